# Optimizing an MI355X kernel written in HIP

```python
import math
import jax, jax.numpy as jnp
from jax import lax
import numpy as np

D_MODEL = 2048
BATCH = 1
SEQ = 8192
DEPTH = 1

CHUNK = 64
NORM_EPS = 1e-6
GDN_HEADS = 8
GDN_HEAD_DIM = 128
GDN_WIDTH = GDN_HEADS * GDN_HEAD_DIM
GDN_CONV = 4
ATT_HEADS = 8
ATT_HEAD_DIM = 128
ATT_WIDTH = ATT_HEADS * ATT_HEAD_DIM
ATT_LEFT_CHUNKS = 8
BAND = (ATT_LEFT_CHUNKS + 1) * CHUNK
REL_MAX = 256
REL_SIZE = REL_MAX + CHUNK
D_FF = 5504
IN_SPLIT = (GDN_WIDTH, GDN_WIDTH, GDN_WIDTH, GDN_WIDTH, GDN_HEADS, GDN_HEADS,
            ATT_WIDTH, ATT_WIDTH, ATT_WIDTH, D_MODEL, D_MODEL)
IN_WIDTH = sum(IN_SPLIT)

kernel_name = "hybrid_gdn_chunkattn_macaron_block"


def rms_norm(x, w):
    xf = x.astype(jnp.float32)
    y = xf * lax.rsqrt(jnp.mean(xf * xf, axis=-1, keepdims=True) + NORM_EPS)
    return (y * w.astype(jnp.float32)).astype(x.dtype)


def l2_norm(x):
    return x * lax.rsqrt(jnp.sum(x * x, axis=-1, keepdims=True) + NORM_EPS)


def swiglu(h, w_gate, w_up, w_down):
    return (jax.nn.silu(h @ w_gate) * (h @ w_up)) @ w_down


def causal_depthwise_conv_silu(x, w):
    K, C = w.shape
    y = lax.conv_general_dilated(
        x, w[:, None, :].astype(x.dtype), window_strides=(1,), padding=[(K - 1, 0)],
        dimension_numbers=("NWC", "WIO", "NWC"), feature_group_count=C)
    return jax.nn.silu(y)


def gated_delta_rule(q, k, v, g, beta):
    B, H, T, Dk = k.shape
    Dv = v.shape[-1]
    n = T // CHUNK
    q = q.reshape(B, H, n, CHUNK, Dk)
    k = k.reshape(B, H, n, CHUNK, Dk)
    v = v.reshape(B, H, n, CHUNK, Dv)
    g = g.reshape(B, H, n, CHUNK)
    beta = beta.reshape(B, H, n, CHUNK)

    G = jnp.cumsum(g, axis=-1)
    causal = jnp.tril(jnp.ones((CHUNK, CHUNK), dtype=bool))
    strict = jnp.tril(jnp.ones((CHUNK, CHUNK), dtype=bool), k=-1)
    decay = jnp.exp(jnp.where(causal, G[..., :, None] - G[..., None, :], -jnp.inf))

    kb = k * beta[..., None]
    A = jnp.where(strict, jnp.einsum('bhnid,bhnjd->bhnij', kb, k) * decay, 0.0)
    eye = jnp.eye(CHUNK, dtype=A.dtype)
    IA = A + eye
    u = lax.linalg.triangular_solve(IA, v * beta[..., None], left_side=True, lower=True)
    w = lax.linalg.triangular_solve(IA, kb * jnp.exp(G)[..., None], left_side=True, lower=True)

    Aqk = jnp.where(causal, jnp.einsum('bhnid,bhnjd->bhnij', q, k) * decay, 0.0)
    qg = q * jnp.exp(G)[..., None]
    kdec = k * jnp.exp(G[..., -1:] - G)[..., None]
    chunk_decay = jnp.exp(G[..., -1])

    def step(S, inp):
        qg_c, kdec_c, u_c, w_c, aqk_c, cd_c = inp
        v_new = u_c - jnp.einsum('bhid,bhde->bhie', w_c, S)
        o_c = jnp.einsum('bhid,bhde->bhie', qg_c, S) + jnp.einsum('bhij,bhje->bhie', aqk_c, v_new)
        S = S * cd_c[..., None, None] + jnp.einsum('bhid,bhie->bhde', kdec_c, v_new)
        return S, o_c

    xs = tuple(jnp.moveaxis(a, 2, 0) for a in (qg, kdec, u, w, Aqk, chunk_decay))
    S0 = jnp.zeros((B, H, Dk, Dv), dtype=q.dtype)
    _, o = lax.scan(step, S0, xs)
    return jnp.moveaxis(o, 0, 2).reshape(B, H, T, Dv)


def gdn_branch(q, k, v, z, a, b, conv_w, A_log, dt_bias, out_norm_w):
    B, T, _ = q.shape
    qkv = causal_depthwise_conv_silu(jnp.concatenate([q, k, v], axis=-1), conv_w)
    q, k, v = jnp.split(qkv, 3, axis=-1)
    heads = lambda t: t.reshape(B, T, GDN_HEADS, GDN_HEAD_DIM).transpose(0, 2, 1, 3).astype(jnp.float32)
    qh = l2_norm(heads(q)) * (GDN_HEAD_DIM ** -0.5)
    kh = l2_norm(heads(k))
    vh = heads(v)
    g = -jnp.exp(A_log.astype(jnp.float32)) * jax.nn.softplus(a.astype(jnp.float32) + dt_bias.astype(jnp.float32))
    beta = jax.nn.sigmoid(b.astype(jnp.float32))
    o = gated_delta_rule(qh, kh, vh, g.transpose(0, 2, 1), beta.transpose(0, 2, 1))
    o = o.transpose(0, 2, 1, 3)
    zf = z.reshape(B, T, GDN_HEADS, GDN_HEAD_DIM).astype(jnp.float32)
    o = rms_norm(o, out_norm_w) * jax.nn.silu(zf)
    return o.reshape(B, T, GDN_WIDTH).astype(z.dtype)


def chunk_attention_branch(q, k, v, q_norm_w, k_norm_w, rel_bias):
    B, T, _ = q.shape
    n = T // CHUNK
    pad = ATT_LEFT_CHUNKS * CHUNK
    heads = lambda t: t.reshape(B, T, ATT_HEADS, ATT_HEAD_DIM).transpose(0, 2, 1, 3)
    qh = rms_norm(heads(q), q_norm_w).astype(jnp.float32)
    kh = rms_norm(heads(k), k_norm_w).astype(jnp.float32)
    vh = heads(v).astype(jnp.float32)

    def band(t):
        tp = jnp.pad(t, ((0, 0), (0, 0), (pad, 0), (0, 0))).reshape(B, ATT_HEADS, n + ATT_LEFT_CHUNKS, CHUNK, ATT_HEAD_DIM)
        return jnp.stack([tp[:, :, s:s + n] for s in range(ATT_LEFT_CHUNKS + 1)], axis=3).reshape(
            B, ATT_HEADS, n, BAND, ATT_HEAD_DIM)

    k_band = band(kh)
    v_band = band(vh)
    qc = qh.reshape(B, ATT_HEADS, n, CHUNK, ATT_HEAD_DIM)
    s = jnp.einsum('bhnqd,bhnkd->bhnqk', qc, k_band) * (ATT_HEAD_DIM ** -0.5)

    i = jnp.arange(CHUNK)[:, None]
    j = jnp.arange(BAND)[None, :]
    rel_idx = jnp.clip(i - j + pad, -(CHUNK - 1), REL_MAX) + (CHUNK - 1)
    bias = rel_bias.astype(jnp.float32)[:, rel_idx]
    key_pos = (jnp.arange(n)[:, None] - ATT_LEFT_CHUNKS) * CHUNK + jnp.arange(BAND)[None, :]
    valid = key_pos >= 0
    s = jnp.where(valid[:, None, :], s + bias[:, None], -jnp.inf)
    p = jax.nn.softmax(s, axis=-1)
    o = jnp.einsum('bhnqk,bhnkd->bhnqd', p, v_band).reshape(B, ATT_HEADS, T, ATT_HEAD_DIM)
    return o.transpose(0, 2, 1, 3).reshape(B, T, ATT_WIDTH).astype(q.dtype)


def setup_inputs(seed: int = 0) -> dict:
    key = jax.random.key(seed)
    ks = jax.random.split(key, 24)
    f32 = jnp.float32
    L = DEPTH
    nrm = lambda k, shape, fan_in: jax.random.normal(k, shape, f32) * (fan_in ** -0.5)
    gain = lambda k, shape: 1.0 + 0.02 * jax.random.normal(k, shape, f32)
    dt = jnp.exp(jax.random.uniform(ks[8], (L, GDN_HEADS), f32, math.log(1e-3), math.log(1e-1)))
    return {
        "x": jax.random.normal(ks[0], (BATCH, SEQ, D_MODEL), f32),
        "ffn1_norm": gain(ks[1], (L, D_MODEL)),
        "ffn1_w_gate": nrm(ks[2], (L, D_MODEL, D_FF), D_MODEL),
        "ffn1_w_up": nrm(ks[3], (L, D_MODEL, D_FF), D_MODEL),
        "ffn1_w_down": nrm(ks[4], (L, D_FF, D_MODEL), D_FF),
        "mix_norm": gain(ks[5], (L, D_MODEL)),
        "w_in": nrm(ks[6], (L, D_MODEL, IN_WIDTH), D_MODEL),
        "gdn_conv": nrm(ks[7], (L, GDN_CONV, 3 * GDN_WIDTH), GDN_CONV),
        "gdn_A_log": jnp.log(jax.random.uniform(ks[9], (L, GDN_HEADS), f32, 1.0, 16.0)),
        "gdn_dt_bias": dt + jnp.log(-jnp.expm1(-dt)),
        "gdn_out_norm": gain(ks[10], (L, GDN_HEAD_DIM)),
        "att_q_norm": gain(ks[11], (L, ATT_HEAD_DIM)),
        "att_k_norm": gain(ks[12], (L, ATT_HEAD_DIM)),
        "att_rel_bias": 0.1 * jax.random.normal(ks[13], (L, ATT_HEADS, REL_SIZE), f32),
        "w_branch_gdn": nrm(ks[14], (L, GDN_WIDTH, D_MODEL), GDN_WIDTH),
        "w_branch_att": nrm(ks[15], (L, ATT_WIDTH, D_MODEL), ATT_WIDTH),
        "w_out": nrm(ks[16], (L, D_MODEL, D_MODEL), D_MODEL),
        "ffn2_norm": gain(ks[17], (L, D_MODEL)),
        "ffn2_w_gate": nrm(ks[18], (L, D_MODEL, D_FF), D_MODEL),
        "ffn2_w_up": nrm(ks[19], (L, D_MODEL, D_FF), D_MODEL),
        "ffn2_w_down": nrm(ks[20], (L, D_FF, D_MODEL), D_FF),
    }


def reference(x, ffn1_norm, ffn1_w_gate, ffn1_w_up, ffn1_w_down, mix_norm, w_in, gdn_conv,
              gdn_A_log, gdn_dt_bias, gdn_out_norm, att_q_norm, att_k_norm, att_rel_bias,
              w_branch_gdn, w_branch_att, w_out, ffn2_norm, ffn2_w_gate, ffn2_w_up, ffn2_w_down):
    split_at = np.cumsum(IN_SPLIT)[:-1].tolist()
    for l in range(DEPTH):
        h = rms_norm(x, ffn1_norm[l])
        x = x + 0.5 * swiglu(h, ffn1_w_gate[l], ffn1_w_up[l], ffn1_w_down[l])

        h = rms_norm(x, mix_norm[l])
        proj = h @ w_in[l]
        (gq, gk, gv, gz, ga, gb, aq, ak, av, gate_gdn, gate_att) = jnp.split(proj, split_at, axis=-1)
        o_gdn = gdn_branch(gq, gk, gv, gz, ga, gb, gdn_conv[l], gdn_A_log[l], gdn_dt_bias[l], gdn_out_norm[l])
        o_att = chunk_attention_branch(aq, ak, av, att_q_norm[l], att_k_norm[l], att_rel_bias[l])
        merged = (jax.nn.sigmoid(gate_gdn) * (o_gdn @ w_branch_gdn[l])
                  + jax.nn.sigmoid(gate_att) * (o_att @ w_branch_att[l]))
        x = x + merged @ w_out[l]

        h = rms_norm(x, ffn2_norm[l])
        x = x + 0.5 * swiglu(h, ffn2_w_gate[l], ffn2_w_up[l], ffn2_w_down[l])
    return x
```

```cpp
#include <hip/hip_runtime.h>
#include <hip/hip_cooperative_groups.h>
#include <cstdio>
#include <cstdint>
namespace cg = cooperative_groups;
namespace pg8 {
#define PG8_LAS __attribute__((address_space(3)))
typedef unsigned short bf16_t;
typedef short bf16x8 __attribute__((ext_vector_type(8)));
typedef float f32x4 __attribute__((ext_vector_type(4)));
typedef unsigned u32x4 __attribute__((ext_vector_type(4)));
constexpr int BM = 256, BK = 64, HALF = 128, HTB = HALF * BK * 2  , STAGE_BYTES = 8 * HTB, NXCD = 8, WGM = 8;

__host__ __device__ __forceinline__ int lds_byte(int r, int c) { const int st = (r >> 4) * 2 + (c >> 5), rr = r & 15, cc = c & 31, ob = rr * 64 + cc * 2; return st * 1024 + (ob ^ (((ob >> 9) & 1) << 5)); }
__host__ __device__ __forceinline__ void stage_rc(int b, int& R, int& C) { const int st = b / 1024, sb = b % 1024, swz = sb ^ (((sb >> 9) & 1) << 5); R = (st >> 1) * 16 + swz / 64; C = (st & 1) * 32 + (swz % 64) / 2; }
__host__ __device__ __forceinline__ int perm32(int rho) { const int n = rho >> 4, i = rho & 15; return 8 * (i >> 2) + 4 * n + (i & 3); }

struct Unit { int pm, pn; };
struct Gemm { const bf16_t* A; const bf16_t* Bt; int M, N, K; };

struct StaticOrder {
    int nM, nN, nwg, G, c;
    __host__ __device__ void init(int M, int N, int G_, int c_) { nM = M / BM; nN = N / BM; nwg = nM * nN; G = G_; c = c_; }
    __host__ __device__ bool next(int i, Unit& u) const {
        const long L = (long)i * G + c; if (L >= nwg) return false;
        int wgid = (int)L; { const int q = nwg / NXCD, r = nwg % NXCD, xcd = wgid % NXCD, off = wgid / NXCD; wgid = (xcd < r ? xcd * (q + 1) : r * (q + 1) + (xcd - r) * q) + off; }
        const int nig = WGM * nN, gid = wgid / nig, fm = gid * WGM, gsz = (nM - fm) < WGM ? (nM - fm) : WGM;
        u.pm = fm + ((wgid % nig) % gsz); u.pn = (wgid % nig) / gsz; return true;
    }
    __device__ __forceinline__ void a_ready(const Unit&) const {}
    __device__ __forceinline__ void done(const Unit&) const {}
};
typedef unsigned u32x2 __attribute__((ext_vector_type(2)));

typedef float f32x2_t __attribute__((ext_vector_type(2))); typedef __bf16 bf16x2_t __attribute__((ext_vector_type(2)));
__device__ __forceinline__ unsigned cvt_pk_bf16(float lo, float hi) { const f32x2_t v = {lo, hi}; const bf16x2_t b = __builtin_convertvector(v, bf16x2_t); return __builtin_bit_cast(unsigned, b); }
__device__ __forceinline__ float bf_lo(unsigned u) { return __uint_as_float(u << 16); }
__device__ __forceinline__ float bf_hi(unsigned u) { return __uint_as_float(u & 0xffff0000u); }
__device__ __forceinline__ float sigmoidf_(float x) { return __builtin_amdgcn_rcpf(1.0f + __expf(-x)); }
__device__ __forceinline__ float siluf_(float x) { return x * sigmoidf_(x); }
constexpr float NORM_EPS = 1e-6f;
constexpr int DM = 2048;
constexpr int NP = 11328;

typedef float f32x2 __attribute__((ext_vector_type(2)));
__device__ __forceinline__ f32x2 swiglu_pk(f32x2 g, f32x2 u, float rs) {
    const f32x2 gs = g * rs, us = u * rs, t = gs * (-1.4426950408889634f);
    f32x2 e; e.x = __builtin_amdgcn_exp2f(t.x); e.y = __builtin_amdgcn_exp2f(t.y);
    const f32x2 d = e + 1.0f;
    f32x2 r; r.x = __builtin_amdgcn_rcpf(d.x); r.y = __builtin_amdgcn_rcpf(d.y);
    return (gs * r) * us;
}
struct EpiSwiglu {
    static constexpr bool PERM = true, AFTER_DRAIN = false;
    bf16_t* O; int ldc; const float* rowss;
    __device__ __forceinline__ void operator()(const f32x4 (&acc)[2][2][4][2], const Unit& u, int wr, int wc, int fr, int fq) const {
        const int row0 = u.pm * BM + wr * 64 + fr; const int col0 = u.pn * 128 + wc * 32 + 8 * fq;
#pragma unroll
        for (int ai = 0; ai < 2; ++ai)
#pragma unroll
            for (int m = 0; m < 4; ++m) { const int row = row0 + ai * HALF + m * 16; const float rs = rsqrtf(rowss[row] * (1.0f / DM) + NORM_EPS);
                const f32x4 g0 = acc[ai][0][m][0], g1 = acc[ai][0][m][1], u0 = acc[ai][1][m][0], u1 = acc[ai][1][m][1];
                const f32x2 a = swiglu_pk((f32x2){g0[0], g0[1]}, (f32x2){u0[0], u0[1]}, rs), b = swiglu_pk((f32x2){g0[2], g0[3]}, (f32x2){u0[2], u0[3]}, rs);
                const f32x2 c = swiglu_pk((f32x2){g1[0], g1[1]}, (f32x2){u1[0], u1[1]}, rs), d = swiglu_pk((f32x2){g1[2], g1[3]}, (f32x2){u1[2], u1[3]}, rs);
                u32x4 w; w.x = cvt_pk_bf16(a.x, a.y); w.y = cvt_pk_bf16(b.x, b.y); w.z = cvt_pk_bf16(c.x, c.y); w.w = cvt_pk_bf16(d.x, d.y);
                *(u32x4*)(O + (size_t)row * ldc + col0) = w; }
    }
};
struct EpiP {
    static constexpr bool PERM = true, AFTER_DRAIN = false;
    bf16_t* P; float* AB; const float* rowss;
    __device__ __forceinline__ void operator()(const f32x4 (&acc)[2][2][4][2], const Unit& u, int wr, int wc, int fr, int fq) const {
        const int row0 = u.pm * BM + wr * 64 + fr;
        if (u.pn < 44) { const int col0 = u.pn * BM + wc * 32 + 8 * fq;
#pragma unroll
            for (int ai = 0; ai < 2; ++ai)
#pragma unroll
                for (int m = 0; m < 4; ++m) { const int row = row0 + ai * HALF + m * 16; const float rs = rsqrtf(rowss[row] * (1.0f / DM) + NORM_EPS);
#pragma unroll
                    for (int bj = 0; bj < 2; ++bj) { const f32x4 v0 = acc[ai][bj][m][0] * rs, v1 = acc[ai][bj][m][1] * rs;
                        u32x4 w; w.x = cvt_pk_bf16(v0[0], v0[1]); w.y = cvt_pk_bf16(v0[2], v0[3]); w.z = cvt_pk_bf16(v1[0], v1[1]); w.w = cvt_pk_bf16(v1[2], v1[3]);
                        *(u32x4*)(P + (size_t)row * NP + col0 + bj * HALF) = w; } }
        } else if (wc == 0 && fq < 2) {
#pragma unroll
            for (int ai = 0; ai < 2; ++ai)
#pragma unroll
                for (int m = 0; m < 4; ++m) { const int row = row0 + ai * HALF + m * 16; const float rs = rsqrtf(rowss[row] * (1.0f / DM) + NORM_EPS);
                    *(f32x4*)(AB + (size_t)row * 16 + 8 * fq) = acc[ai][0][m][0] * rs; *(f32x4*)(AB + (size_t)row * 16 + 8 * fq + 4) = acc[ai][0][m][1] * rs; }
        }
    }
};
template <int WHICH> struct EpiGate {
    static constexpr bool PERM = true, AFTER_DRAIN = false;
    bf16_t* Mo; const bf16_t* P; int goff;
    __device__ __forceinline__ void operator()(const f32x4 (&acc)[2][2][4][2], const Unit& u, int wr, int wc, int fr, int fq) const {
        const int row0 = u.pm * BM + wr * 64 + fr; const int col0 = u.pn * BM + wc * 32 + 8 * fq;
#pragma unroll
        for (int ai = 0; ai < 2; ++ai)
#pragma unroll
            for (int m = 0; m < 4; ++m) { const int row = row0 + ai * HALF + m * 16;
#pragma unroll
                for (int bj = 0; bj < 2; ++bj) { const int col = col0 + bj * HALF;
                    const u32x4 g = *(const u32x4*)(P + (size_t)row * NP + goff + col);
                    const f32x4 a0 = acc[ai][bj][m][0], a1 = acc[ai][bj][m][1];
                    float v[8];
                    v[0] = sigmoidf_(bf_lo(g.x)) * a0[0]; v[1] = sigmoidf_(bf_hi(g.x)) * a0[1]; v[2] = sigmoidf_(bf_lo(g.y)) * a0[2]; v[3] = sigmoidf_(bf_hi(g.y)) * a0[3];
                    v[4] = sigmoidf_(bf_lo(g.z)) * a1[0]; v[5] = sigmoidf_(bf_hi(g.z)) * a1[1]; v[6] = sigmoidf_(bf_lo(g.w)) * a1[2]; v[7] = sigmoidf_(bf_hi(g.w)) * a1[3];
                    bf16_t* op = Mo + (size_t)row * DM + col;
                    if (WHICH == 1) { const u32x4 o = *(const u32x4*)op;
                        v[0] += bf_lo(o.x); v[1] += bf_hi(o.x); v[2] += bf_lo(o.y); v[3] += bf_hi(o.y); v[4] += bf_lo(o.z); v[5] += bf_hi(o.z); v[6] += bf_lo(o.w); v[7] += bf_hi(o.w); }
                    u32x4 w; w.x = cvt_pk_bf16(v[0], v[1]); w.y = cvt_pk_bf16(v[2], v[3]); w.z = cvt_pk_bf16(v[4], v[5]); w.w = cvt_pk_bf16(v[6], v[7]);
                    *(u32x4*)op = w; } }
    }
};
template <bool BF> struct EpiResid {
    static constexpr bool PERM = false, AFTER_DRAIN = false;
    const float* R; float* out; bf16_t* XB; float* rowss; float scale;
    __device__ __forceinline__ void operator()(const f32x4 (&acc)[2][2][4][2], const Unit& u, int wr, int wc, int fr, int fq) const {
        const int row0 = u.pm * BM + wr * 64 + fr; const int col0 = u.pn * BM + wc * 32 + 4 * fq;
#pragma unroll
        for (int ai = 0; ai < 2; ++ai)
#pragma unroll
            for (int m = 0; m < 4; ++m) { const int row = row0 + ai * HALF + m * 16; float ss = 0.f;
#pragma unroll
                for (int bj = 0; bj < 2; ++bj)
#pragma unroll
                    for (int n = 0; n < 2; ++n) { const size_t off = (size_t)row * DM + col0 + bj * HALF + n * 16;
                        const f32x4 r = *(const f32x4*)(R + off); const f32x4 y = r + acc[ai][bj][m][n] * scale;
                        *(f32x4*)(out + off) = y;
                        if (BF) { u32x2 w; w.x = cvt_pk_bf16(y[0], y[1]); w.y = cvt_pk_bf16(y[2], y[3]); *(u32x2*)(XB + off) = w; ss += (y[0] * y[0] + y[1] * y[1]) + (y[2] * y[2] + y[3] * y[3]); } }
                if (BF) { ss += __shfl_xor(ss, 16); ss += __shfl_xor(ss, 32); if (fq == 0) atomicAdd(rowss + row, ss); } }
    }
};

template <class Epi, class Sched, bool ALIGN_EPI = false, bool SP2 = false>
__device__ __forceinline__ void gemm_phase(PG8_LAS unsigned char* lds, const Gemm g, const Sched& S, const Epi& E) {
    const int tid = threadIdx.x, wid = __builtin_amdgcn_readfirstlane(tid >> 6), lane = tid & 63, wr = wid >> 2, wc = wid & 3, fr = lane & 15, fq = lane >> 4;
    const int K = g.K, nt = K / BK;
    unsigned voffA[2], voffB[2];
#pragma unroll
    for (int i = 0; i < 2; ++i) { int R, C; stage_rc(tid * 16 + i * 8192, R, C); const int Rb = Epi::PERM ? ((R & ~31) + perm32(R & 31)) : R;
        voffA[i] = (unsigned)(R * K + C) * 2u; voffB[i] = (unsigned)(Rb * K + C) * 2u; }
    const size_t kstep = (size_t)(BK * 2);
    const size_t hstep = (size_t)HALF * K * 2;
    const size_t tstep = 2 * hstep;
    const unsigned ldsw = (unsigned)wid * 1024u;
    const int aoff = lds_byte(wr * 64 + fr, fq * 8), boff = lds_byte(wc * 32 + fr, fq * 8);
#define PG8_SA(b, h) (((b) * 2 + (h)) * HTB)
#define PG8_SB(b, h) ((4 + (b) * 2 + (h)) * HTB)
#define PG8_STAGE(bufoff, gbase, voff) do { _Pragma("unroll") for (int _i = 0; _i < 2; ++_i) \
        __builtin_amdgcn_global_load_lds((const unsigned*)((const char*)(gbase) + (voff)[_i]), (PG8_LAS unsigned*)(lds + (bufoff) + ldsw + _i * 8192), 16, 0, 0); } while (0)
#define PG8_LDA(dst, b, h) do { _Pragma("unroll") for (int m = 0; m < 4; ++m) _Pragma("unroll") for (int k = 0; k < 2; ++k) dst[m][k] = *(const PG8_LAS bf16x8*)(lds + PG8_SA(b, h) + aoff + m * 2048 + k * 1024); } while (0)
#define PG8_LDB(dst, b, h) do { _Pragma("unroll") for (int n = 0; n < 2; ++n) _Pragma("unroll") for (int k = 0; k < 2; ++k) dst[n][k] = *(const PG8_LAS bf16x8*)(lds + PG8_SB(b, h) + boff + n * 2048 + k * 1024); } while (0)
#define PG8_MMA(ai, bj, At, Bt) do { __builtin_amdgcn_s_setprio(1); _Pragma("unroll") for (int m = 0; m < 4; ++m) _Pragma("unroll") for (int n = 0; n < 2; ++n) _Pragma("unroll") for (int k = 0; k < 2; ++k) \
        acc[ai][bj][m][n] = __builtin_amdgcn_mfma_f32_16x16x32_bf16(Bt[n][k], At[m][k], acc[ai][bj][m][n], 0, 0, 0); __builtin_amdgcn_s_setprio(0); } while (0)
#define PG8_WAIT_V(n) asm volatile("s_waitcnt vmcnt(" #n ")" ::: "memory")
#define PG8_WAIT_L(n) asm volatile("s_waitcnt lgkmcnt(" #n ")" ::: "memory")
#define PG8_BAR __builtin_amdgcn_s_barrier()
#define PG8_SCHED __builtin_amdgcn_sched_barrier(0)
    Unit cur, nxt; int ui = 0;
    if (!S.next(0, cur)) return;
    f32x4 acc[2][2][4][2];
#pragma unroll
    for (int a = 0; a < 2; ++a)
#pragma unroll
        for (int b = 0; b < 2; ++b)
#pragma unroll
            for (int m = 0; m < 4; ++m)
#pragma unroll
                for (int n = 0; n < 2; ++n) acc[a][b][m][n] = (f32x4){0.f, 0.f, 0.f, 0.f};
    bf16x8 At[4][2], B0[2][2], B1[2][2];
    const char* cA = (const char*)g.A + (size_t)cur.pm * tstep; const char* cB = (const char*)g.Bt + (size_t)cur.pn * tstep;
    S.a_ready(cur);
    if constexpr (SP2) {
        PG8_STAGE(PG8_SB(0, 0), cB, voffB); PG8_STAGE(PG8_SB(0, 1), cB + hstep, voffB); PG8_STAGE(PG8_SA(0, 0), cA, voffA); PG8_STAGE(PG8_SA(0, 1), cA + hstep, voffA);
        if (wr == 1) PG8_BAR;
        PG8_WAIT_V(2); PG8_BAR;
        PG8_STAGE(PG8_SB(1, 0), cB + kstep, voffB); PG8_STAGE(PG8_SA(1, 0), cA + kstep, voffA); PG8_STAGE(PG8_SB(1, 1), cB + hstep + kstep, voffB);
        PG8_WAIT_V(6); PG8_BAR;
    } else {
        PG8_STAGE(PG8_SB(0, 0), cB, voffB); PG8_STAGE(PG8_SA(0, 0), cA, voffA); PG8_STAGE(PG8_SB(0, 1), cB + hstep, voffB); PG8_STAGE(PG8_SA(0, 1), cA + hstep, voffA);
        if (wr == 1) PG8_BAR;
        PG8_WAIT_V(4); PG8_BAR;
        PG8_STAGE(PG8_SB(1, 0), cB + kstep, voffB); PG8_STAGE(PG8_SA(1, 0), cA + kstep, voffA); PG8_STAGE(PG8_SB(1, 1), cB + hstep + kstep, voffB);
        PG8_WAIT_V(6); PG8_BAR;
    }
    for (;;) {
        const bool has_next = S.next(ui + 1, nxt);
        const char* nA = has_next ? (const char*)g.A + (size_t)nxt.pm * tstep : cA; const char* nB = has_next ? (const char*)g.Bt + (size_t)nxt.pn * tstep : cB;
        for (int t = 0; t < nt; t += 2) {
            const bool last = (t == nt - 2);
            const char* a1 = cA + (size_t)(t + 1) * kstep;
            const char* a2 = last ? nA : cA + (size_t)(t + 2) * kstep; const char* b2 = last ? nB : cB + (size_t)(t + 2) * kstep;
            const char* a3 = a2 + kstep; const char* b3 = b2 + kstep;
            if (last && has_next) S.a_ready(nxt);
            if constexpr (SP2) {
            PG8_LDB(B0, 0, 0); PG8_LDB(B1, 0, 1); PG8_SCHED; PG8_LDA(At, 0, 0); PG8_STAGE(PG8_SA(1, 1), a1 + hstep, voffA);
            PG8_WAIT_V(8); PG8_WAIT_L(0); PG8_BAR; PG8_MMA(0, 0, At, B0); PG8_MMA(0, 1, At, B1); PG8_BAR; PG8_SCHED;
            PG8_LDA(At, 0, 1); PG8_STAGE(PG8_SB(0, 0), b2, voffB); PG8_STAGE(PG8_SB(0, 1), b2 + hstep, voffB); PG8_STAGE(PG8_SA(0, 0), a2, voffA);
            PG8_WAIT_V(8); PG8_WAIT_L(0); PG8_BAR; PG8_MMA(1, 0, At, B0); PG8_MMA(1, 1, At, B1); PG8_BAR; PG8_SCHED;
            PG8_LDB(B0, 1, 0); PG8_LDB(B1, 1, 1); PG8_SCHED; PG8_LDA(At, 1, 0); PG8_STAGE(PG8_SA(0, 1), a2 + hstep, voffA);
            PG8_WAIT_V(8); PG8_WAIT_L(0); PG8_BAR; PG8_MMA(0, 0, At, B0); PG8_MMA(0, 1, At, B1); PG8_BAR; PG8_SCHED;
            PG8_LDA(At, 1, 1); PG8_STAGE(PG8_SB(1, 0), b3, voffB); PG8_STAGE(PG8_SB(1, 1), b3 + hstep, voffB); PG8_STAGE(PG8_SA(1, 0), a3, voffA);
            PG8_WAIT_V(8); PG8_WAIT_L(0); PG8_BAR; PG8_MMA(1, 0, At, B0); PG8_MMA(1, 1, At, B1); PG8_BAR; PG8_SCHED;
            } else {
            PG8_LDB(B0, 0, 0); PG8_SCHED; PG8_LDA(At, 0, 0); PG8_STAGE(PG8_SA(1, 1), a1 + hstep, voffA);
            PG8_WAIT_L(8); PG8_BAR; PG8_WAIT_L(0); PG8_MMA(0, 0, At, B0); PG8_BAR; PG8_SCHED;
            PG8_LDB(B1, 0, 1); PG8_STAGE(PG8_SB(0, 0), b2, voffB);
            PG8_BAR; PG8_WAIT_L(0); PG8_MMA(0, 1, At, B1); PG8_BAR;
            PG8_LDA(At, 0, 1); PG8_STAGE(PG8_SA(0, 0), a2, voffA);
            PG8_BAR; PG8_WAIT_L(0); PG8_MMA(1, 0, At, B0); PG8_BAR; PG8_SCHED;
            PG8_STAGE(PG8_SB(0, 1), b2 + hstep, voffB);
            PG8_WAIT_V(6); PG8_BAR; PG8_MMA(1, 1, At, B1); PG8_BAR;
            PG8_LDB(B0, 1, 0); PG8_SCHED; PG8_LDA(At, 1, 0); PG8_STAGE(PG8_SA(0, 1), a2 + hstep, voffA);
            PG8_WAIT_L(8); PG8_BAR; PG8_WAIT_L(0); PG8_MMA(0, 0, At, B0); PG8_BAR; PG8_SCHED;
            PG8_LDB(B1, 1, 1); PG8_STAGE(PG8_SB(1, 0), b3, voffB);
            PG8_BAR; PG8_WAIT_L(0); PG8_MMA(0, 1, At, B1); PG8_BAR;
            PG8_LDA(At, 1, 1); PG8_STAGE(PG8_SA(1, 0), a3, voffA);
            PG8_BAR; PG8_WAIT_L(0); PG8_MMA(1, 0, At, B0); PG8_BAR; PG8_SCHED;
            PG8_STAGE(PG8_SB(1, 1), b3 + hstep, voffB);
            PG8_WAIT_V(6); PG8_BAR; PG8_MMA(1, 1, At, B1); PG8_BAR;
            }
        }
        if constexpr (ALIGN_EPI) { if (wr == 0) PG8_BAR; }
        if constexpr (!Epi::AFTER_DRAIN) { E(acc, cur, wr, wc, fr, fq); S.done(cur); }
        if (!has_next) break;
#pragma unroll
        for (int a = 0; a < 2; ++a)
#pragma unroll
            for (int b = 0; b < 2; ++b)
#pragma unroll
                for (int m = 0; m < 4; ++m)
#pragma unroll
                    for (int n = 0; n < 2; ++n) acc[a][b][m][n] = (f32x4){0.f, 0.f, 0.f, 0.f};
        cur = nxt; cA = nA; cB = nB; ++ui;
        if constexpr (ALIGN_EPI) { if (wr == 1) PG8_BAR; }
    }
    PG8_WAIT_V(0);
    if constexpr (!ALIGN_EPI) { if (wr == 0) PG8_BAR; }
    PG8_BAR;
    if constexpr (Epi::AFTER_DRAIN) { E.fused(acc, cur, wr, wc, fr, fq, lds, wid, lane); S.done(cur); }
#undef PG8_SA
#undef PG8_SB
#undef PG8_STAGE
#undef PG8_LDA
#undef PG8_LDB
#undef PG8_MMA
#undef PG8_WAIT_V
#undef PG8_WAIT_L
#undef PG8_BAR
#undef PG8_SCHED
}
}
#define LAS __attribute__((address_space(3)))
using pg8::bf16_t; using pg8::bf16x8; using pg8::f32x4; using pg8::u32x4; using pg8::u32x2; using pg8::cvt_pk_bf16; using pg8::bf_lo; using pg8::bf_hi; using pg8::siluf_;
#ifndef LATE_CVT
#define LATE_CVT 1
#endif
#ifndef N_LAUNCH
#define N_LAUNCH 1
#endif
constexpr int T = 8192, D = 2048, FF = 5504, NGU = 11008, NP = pg8::NP, NINP = 11520, H = 8, NCH = 128;
constexpr int P_GQ = 0, P_GK = 1024, P_GV = 2048, P_GZ = 3072, P_AQ = 4096, P_AK = 5120, P_AV = 6144, P_G1 = 7168, P_G2 = 9216;
constexpr float EPS = 1e-6f, L2E = 1.4426950408889634f;
constexpr size_t MiB = 1u << 20;
constexpr size_t WS_CTL = 0;
constexpr size_t WS_WIN = 1 * MiB, WS_WA = 46 * MiB, WS_WB = 50 * MiB, WS_WOUT = 54 * MiB, WS_WGU2 = 62 * MiB, WS_WD2 = 105 * MiB;
constexpr size_t WS_XB = 127 * MiB, WS_OG = 127 * MiB, WS_OA = 143 * MiB;
constexpr size_t WS_P = 159 * MiB;
constexpr size_t WS_WGU1 = 159 * MiB, WS_WD1 = 202 * MiB, WS_ACT1 = 224 * MiB, WS_ACT2 = 159 * MiB;
constexpr size_t WS_WN = 336 * MiB, WS_QG = 352 * MiB, WS_KDT = 368 * MiB, WS_U = 384 * MiB, WS_AQK = 416 * MiB, WS_M = 336 * MiB, WS_ORAW = 424 * MiB, WS_END = 440 * MiB;
constexpr int CW_SS1 = 0, CW_SS2 = 8192, CW_SS3 = 16384, CW_CD = 24576, CW_SHIFT = 25600, CW_AB = 32768;
constexpr int LDS_BYTES = 147456;
constexpr size_t WS_BAR = 768 * 1024;

#define LDS_WAIT() asm volatile("s_waitcnt lgkmcnt(0)" ::: "memory")
#define BAR_LDS() asm volatile("s_waitcnt lgkmcnt(0)\n\ts_barrier" ::: "memory")
__device__ __forceinline__ float wave_sum(float v) {
#pragma unroll
    for (int o = 1; o < 64; o <<= 1) v += __shfl_xor(v, o);
    return v;
}
__device__ __forceinline__ bf16_t f2bf1(float x) { return (bf16_t)(cvt_pk_bf16(x, 0.f) & 0xffffu); }
__device__ __forceinline__ void unpack16(const u32x4 a, const u32x4 b, float (&o)[16]) {
    o[0] = bf_lo(a.x); o[1] = bf_hi(a.x); o[2] = bf_lo(a.y); o[3] = bf_hi(a.y); o[4] = bf_lo(a.z); o[5] = bf_hi(a.z); o[6] = bf_lo(a.w); o[7] = bf_hi(a.w);
    o[8] = bf_lo(b.x); o[9] = bf_hi(b.x); o[10] = bf_lo(b.y); o[11] = bf_hi(b.y); o[12] = bf_lo(b.z); o[13] = bf_hi(b.z); o[14] = bf_lo(b.w); o[15] = bf_hi(b.w);
}
__device__ __forceinline__ void ld16bf(const bf16_t* p, float (&o)[16]) { unpack16(*(const u32x4*)p, *(const u32x4*)(p + 8), o); }
__device__ __forceinline__ void ld16f(const float* p, float (&o)[16]) {
#pragma unroll
    for (int e = 0; e < 4; ++e) { const f32x4 w = *(const f32x4*)(p + 4 * e); o[4 * e] = w[0]; o[4 * e + 1] = w[1]; o[4 * e + 2] = w[2]; o[4 * e + 3] = w[3]; }
}
__device__ __forceinline__ void pack16(const float (&v)[16], u32x4& a, u32x4& b) {
    a.x = cvt_pk_bf16(v[0], v[1]); a.y = cvt_pk_bf16(v[2], v[3]); a.z = cvt_pk_bf16(v[4], v[5]); a.w = cvt_pk_bf16(v[6], v[7]);
    b.x = cvt_pk_bf16(v[8], v[9]); b.y = cvt_pk_bf16(v[10], v[11]); b.z = cvt_pk_bf16(v[12], v[13]); b.w = cvt_pk_bf16(v[14], v[15]);
}
__device__ __forceinline__ void st16bf_g(bf16_t* p, const float (&v)[16]) { u32x4 a, b; pack16(v, a, b); *(u32x4*)p = a; *(u32x4*)(p + 8) = b; }
__device__ __forceinline__ void st16bf_l(LAS bf16_t* p, const float (&v)[16]) { u32x4 a, b; pack16(v, a, b); *(LAS u32x4*)p = a; *(LAS u32x4*)(p + 8) = b; }
__device__ __forceinline__ bf16x8 mk8(unsigned a, unsigned b, unsigned c, unsigned d) { const u32x4 w = {a, b, c, d}; return __builtin_bit_cast(bf16x8, w); }
#define MFMA16(a, b, c) __builtin_amdgcn_mfma_f32_16x16x32_bf16((a), (b), (c), 0, 0, 0)
typedef short bf16x4 __attribute__((ext_vector_type(4)));
#define MFMA16K16(a, b, c) __builtin_amdgcn_mfma_f32_16x16x16bf16_1k((a), (b), (c), 0, 0, 0)
__device__ __forceinline__ bf16x4 mk4(float a, float b, float c, float d) { const u32x2 w = {cvt_pk_bf16(a, b), cvt_pk_bf16(c, d)}; return __builtin_bit_cast(bf16x4, w); }

struct CvtDesc { const float* W; bf16_t* WT; const float* ks; int ldN, srcn0, nvalid, K, k0, dstrow0; };
template <bool NT> __device__ __forceinline__ void cvt_load(const CvtDesc& d, int lane, f32x4 (&v)[16]) {
    const int kr = lane >> 4, nc = (lane & 15) * 4;
#pragma unroll
    for (int i = 0; i < 16; ++i) { const int k = i * 4 + kr; const f32x4* src = (const f32x4*)(d.W + (size_t)(d.k0 + k) * d.ldN + d.srcn0 + nc);
        v[i] = (nc < d.nvalid) ? (NT ? __builtin_nontemporal_load(src) : *src) : (f32x4){0.f, 0.f, 0.f, 0.f}; }
}
template <bool NT> __device__ __forceinline__ void cvt_store(const CvtDesc& d, const f32x4 (&v)[16], LAS float* scr, int lane) {
    const int kr = lane >> 4, nc = (lane & 15) * 4;
#pragma unroll
    for (int i = 0; i < 16; ++i) { const int k = i * 4 + kr; const float s = d.ks ? d.ks[d.k0 + k] : 1.f; LAS float* p = scr + k * 65 + nc;
        p[0] = v[i][0] * s; p[1] = v[i][1] * s; p[2] = v[i][2] * s; p[3] = v[i][3] * s; }
    LDS_WAIT();
    const int c = lane & 7, nrow = lane >> 3;
#pragma unroll
    for (int j = 0; j < 8; ++j) { const int n = j * 8 + nrow; const LAS float* s = scr + (8 * c) * 65 + n;
        u32x4 o; o.x = cvt_pk_bf16(s[0], s[65]); o.y = cvt_pk_bf16(s[130], s[195]); o.z = cvt_pk_bf16(s[260], s[325]); o.w = cvt_pk_bf16(s[390], s[455]);
        u32x4* dst = (u32x4*)(d.WT + (size_t)(d.dstrow0 + n) * d.K + d.k0 + 8 * c);
        if (NT) __builtin_nontemporal_store(o, dst); else *dst = o; }
    LDS_WAIT();
}
struct Ptrs {
    const float* in[21]; float* out; unsigned char* ws;
};
constexpr int I_GU = 32 * 172, I_DN = 86 * 32, I_IN = 32 * 180, I_AB = 16 * 32, I_OUT = 32 * 32;
constexpr int NITEMS = 2 * (I_GU + I_DN) + I_IN + 2 * I_AB + I_OUT, N_EARLY = I_GU + I_DN + I_IN, N_LATE1 = 6200;
__device__ __forceinline__ CvtDesc cvt_gu_desc(int r, const float* Wg, const float* Wu, const float* nrm, bf16_t* WT) {
    const int kb = r % 32, nb = r / 32, pn = nb >> 2, half = (nb & 3) >> 1, j0 = (nb & 1) * 64;
    return CvtDesc{half ? Wu : Wg, WT, nrm, FF, pn * 128 + j0, 64, D, kb * 64, nb * 64};
}
__device__ __forceinline__ CvtDesc cvt_decode(const Ptrs& A, int it) {
    unsigned char* ws = A.ws; int r = it;
    if (r < I_GU) return cvt_gu_desc(r, A.in[2], A.in[3], A.in[1], (bf16_t*)(ws + WS_WGU1)); r -= I_GU;
    if (r < I_DN) return CvtDesc{A.in[4], (bf16_t*)(ws + WS_WD1), nullptr, D, (r / 86) * 64, 64, FF, (r % 86) * 64, (r / 86) * 64}; r -= I_DN;
    if (r < I_IN) { const int kb = r % 32, nb = r / 32, c0 = nb * 64; int src, nv;
        if (c0 < 4096) { src = c0; nv = 64; } else if (c0 < 11264) { src = c0 + 16; nv = 64; } else if (c0 == 11264) { src = 4096; nv = 16; } else { src = 0; nv = 0; }
        return CvtDesc{A.in[6], (bf16_t*)(ws + WS_WIN), A.in[5], 11280, src, nv, D, kb * 64, c0}; } r -= I_IN;
    if (r < I_GU) return cvt_gu_desc(r, A.in[18], A.in[19], A.in[17], (bf16_t*)(ws + WS_WGU2)); r -= I_GU;
    if (r < I_DN) return CvtDesc{A.in[20], (bf16_t*)(ws + WS_WD2), nullptr, D, (r / 86) * 64, 64, FF, (r % 86) * 64, (r / 86) * 64}; r -= I_DN;
    if (r < I_AB) return CvtDesc{A.in[14], (bf16_t*)(ws + WS_WA), nullptr, D, (r / 16) * 64, 64, 1024, (r % 16) * 64, (r / 16) * 64}; r -= I_AB;
    if (r < I_AB) return CvtDesc{A.in[15], (bf16_t*)(ws + WS_WB), nullptr, D, (r / 16) * 64, 64, 1024, (r % 16) * 64, (r / 16) * 64}; r -= I_AB;
    return CvtDesc{A.in[16], (bf16_t*)(ws + WS_WOUT), nullptr, D, (r / 32) * 64, 64, D, (r % 32) * 64, (r / 32) * 64};
}
template <bool NT = false> __device__ __forceinline__ void cvt_items(const Ptrs& A, LAS unsigned char* lds, int gw, int NGW, int it_lo, int it_hi) {
    const int tid = threadIdx.x, lane = tid & 63, wave = tid >> 6;
    LAS float* scr = (LAS float*)(lds + wave * 16640);
    int it = it_lo + gw; if (it >= it_hi) return;
    CvtDesc d = cvt_decode(A, it); f32x4 v[16]; cvt_load<NT>(d, lane, v);
    for (;;) {
        const int itn = it + NGW; const bool has = itn < it_hi;
        CvtDesc dn = d; f32x4 w[16];
        if (has) { dn = cvt_decode(A, itn); cvt_load<NT>(dn, lane, w); }
        cvt_store<NT>(d, v, scr, lane);
        if (!has) break;
        d = dn; it = itn;
#pragma unroll
        for (int i = 0; i < 16; ++i) v[i] = w[i];
    }
}
__device__ __forceinline__ void p0_prologue(const Ptrs& A, LAS unsigned char* lds, int vcu, int G) {
    const int tid = threadIdx.x, lane = tid & 63, wave = tid >> 6;
    unsigned char* ws = A.ws; float* ctl = (float*)(ws + WS_CTL);
    const int gw = vcu * 8 + wave, NGW = G * 8;
    cvt_items(A, lds, gw, NGW, 0, LATE_CVT ? N_EARLY : NITEMS);
    const float* x = A.in[0]; bf16_t* XB = (bf16_t*)(ws + WS_XB);
    for (int m = gw; m < T; m += NGW) {
        const f32x4* xr = (const f32x4*)(x + (size_t)m * D) + lane; f32x4 v[8]; float s = 0.f;
#pragma unroll
        for (int j = 0; j < 8; ++j) { v[j] = xr[64 * j]; s += (v[j][0] * v[j][0] + v[j][1] * v[j][1]) + (v[j][2] * v[j][2] + v[j][3] * v[j][3]); }
        s = wave_sum(s);
        u32x2* o8 = (u32x2*)(XB + (size_t)m * D) + lane;
#pragma unroll
        for (int j = 0; j < 8; ++j) { u32x2 w; w.x = cvt_pk_bf16(v[j][0], v[j][1]); w.y = cvt_pk_bf16(v[j][2], v[j][3]); o8[64 * j] = w; }
        if (lane == 0) ctl[CW_SS1 + m] = s;
    }
    for (int i = vcu * 512 + tid; i < 16384; i += G * 512) ctl[CW_SS2 + i] = 0.f;
    if (vcu == 0 && wave == 0) {
        const float* qw = A.in[11]; const float* kw = A.in[12];
        float mq = fmaxf(fabsf(qw[lane]), fabsf(qw[lane + 64])), mk = fmaxf(fabsf(kw[lane]), fabsf(kw[lane + 64]));
#pragma unroll
        for (int o = 1; o < 64; o <<= 1) { mq = fmaxf(mq, __shfl_xor(mq, o)); mk = fmaxf(mk, __shfl_xor(mk, o)); }
        if (lane == 0) ctl[CW_SHIFT] = 11.313708498984761f * mq * mk * L2E;
    }
}
#define RLX_AGENT __ATOMIC_RELAXED, __HIP_MEMORY_SCOPE_AGENT
#define XB_TMO      128
#define XB_XCNT(j)  (256  + 64 * (j))
#define XB_XSUB(j)  (1280 + 64 * (j))
#define XB_XGEN(j)  (2304 + 64 * (j))
#define XB_TOP      3328
#define XB_TOPGEN   3392
#define XCD_BAR_WORDS 3456
#define XB_SPIN_CAP (1u << 18)

__device__ __forceinline__ unsigned xb_ld(unsigned* p)              { return __hip_atomic_load(p, __ATOMIC_RELAXED, __HIP_MEMORY_SCOPE_AGENT); }
__device__ __forceinline__ unsigned xb_add(unsigned* p, unsigned v) { return __hip_atomic_fetch_add(p, v, __ATOMIC_RELAXED, __HIP_MEMORY_SCOPE_AGENT); }
__device__ __forceinline__ unsigned xb_xcc_id() { return (unsigned)__builtin_amdgcn_s_getreg((3 << 11) | 20) & 0xFu; }
#define XB_SPIN(cond, bar) do { unsigned _sp = 0; while (cond) { __builtin_amdgcn_s_sleep(1); \
    if ((++_sp & 255u) == 0u) { if (xb_ld(&(bar)[XB_TMO])) break; if (_sp > XB_SPIN_CAP) { atomicAdd(&(bar)[XB_TMO], 1u); break; } } } } while (0)

struct XcdBarrier {
    unsigned* bar; unsigned x;
    volatile LAS unsigned* st;
};

__device__ __forceinline__ XcdBarrier xcd_barrier_post(unsigned* bar, volatile LAS unsigned* st) {
    XcdBarrier b; b.bar = bar; b.x = xb_xcc_id(); b.st = st;
    if (threadIdx.x == 0) (void)xb_add(&bar[XB_XCNT(b.x)], 1u);
    return b;
}
__device__ __forceinline__ void xcd_barrier_complete(unsigned* bar, unsigned x, unsigned& nloc, unsigned& nx) {
    const unsigned G = gridDim.x * gridDim.y * gridDim.z;
    unsigned sum, cnt, mine, sp = 0u;
    for (;;) {
        sum = 0u; cnt = 0u; mine = 0u;
#pragma unroll
        for (unsigned j = 0; j < 16; ++j) { const unsigned c = xb_ld(&bar[XB_XCNT(j)]); sum += c; cnt += (c > 0u) ? 1u : 0u; mine = (j == x) ? c : mine; }
        if (sum == G) break;
        __builtin_amdgcn_s_sleep(1);
        if ((++sp & 255u) == 0u) { if (xb_ld(&bar[XB_TMO])) break; if (sp > XB_SPIN_CAP) { atomicAdd(&bar[XB_TMO], 1u); break; } }
    }
    nloc = mine > 0u ? mine : 1u; nx = cnt > 0u ? cnt : 1u;
}

__device__ __forceinline__ void xcd_barrier(const XcdBarrier& b) {
    asm volatile("s_waitcnt vmcnt(0)" ::: "memory");
    __syncthreads();
    if (threadIdx.x == 0) {
        unsigned* bar = b.bar;
        __builtin_amdgcn_s_waitcnt(0);
        unsigned nloc = b.st[0], nx = b.st[1];
        if (nloc == 0u) { xcd_barrier_complete(bar, b.x, nloc, nx); b.st[0] = nloc; b.st[1] = nx; }
        const unsigned old = xb_add(&bar[XB_XSUB(b.x)], 1u);
        const unsigned gen = old / nloc;
        if (old + 1u == (gen + 1u) * nloc) {
            __builtin_amdgcn_fence(__ATOMIC_RELEASE, "agent");
            asm volatile("s_waitcnt vmcnt(0)" ::: "memory");
            const unsigned og = xb_add(&bar[XB_TOP], 1u);
            const unsigned tg = og / nx;
            if (og + 1u == (tg + 1u) * nx) xb_add(&bar[XB_TOPGEN], 1u);
            else XB_SPIN(xb_ld(&bar[XB_TOPGEN]) == tg, bar);
            __builtin_amdgcn_fence(__ATOMIC_ACQUIRE, "agent");
            xb_add(&bar[XB_XGEN(b.x)], 1u);
            asm volatile("s_waitcnt vmcnt(0)" ::: "memory");
        } else {
            XB_SPIN(xb_ld(&bar[XB_XGEN(b.x)]) == gen, bar);
            __builtin_amdgcn_fence(__ATOMIC_ACQUIRE, "agent");
            asm volatile("s_waitcnt vmcnt(0)" ::: "memory");
        }
    }
    __syncthreads();
}
template <int MODE = 7> __device__ __forceinline__ void gdn_prep_unit(LAS unsigned char* lds, int c, int h, bf16_t* P, const float* AB, const float* convw, const float* A_log, const float* dt_bias, const float* kw,
                                              bf16_t* WN, bf16_t* QG, bf16_t* KDT, float* U, bf16_t* AQK, float* CD) {
    const int tid = threadIdx.x, lane = tid & 63, wave = __builtin_amdgcn_readfirstlane(tid >> 6);
    LAS bf16_t* KT = (LAS bf16_t*)(lds); LAS bf16_t* KBT = (LAS bf16_t*)(lds + 17408); LAS bf16_t* QT = (LAS bf16_t*)(lds + 34816);
    LAS float* X = (LAS float*)(lds + 52224); LAS float* AS = (LAS float*)(lds + 117760);
    LAS float* GS = (LAS float*)(lds + 134144); LAS float* BS = GS + 64; LAS float* GC = GS + 128; LAS float* ED = GS + 192;
    const int i = tid >> 3, sub = tid & 7, d0 = sub * 16, t = c * 64 + i;
    float ab_a = 0.f, ab_b = 0.f;
    if (sub == 0) { ab_a = AB[(size_t)t * 16 + h]; ab_b = AB[(size_t)t * 16 + 8 + h]; }
    u32x4 av0 = {0u, 0u, 0u, 0u}, av1 = {0u, 0u, 0u, 0u};
    if (MODE & 1) {   bf16_t* kp = P + (size_t)t * NP + P_AK + h * 128 + d0; const bf16_t* vp = P + (size_t)t * NP + P_AV + h * 128 + d0;
        float kv[16], kwv[16]; ld16bf(kp, kv); av0 = *(const u32x4*)vp; av1 = *(const u32x4*)(vp + 8); ld16f(kw + d0, kwv);
        float ss = 0.f;
#pragma unroll
        for (int e = 0; e < 16; ++e) ss += kv[e] * kv[e];
        ss += __shfl_xor(ss, 1); ss += __shfl_xor(ss, 2); ss += __shfl_xor(ss, 4);
        const float rs = rsqrtf(ss * (1.0f / 128.0f) + EPS);
#pragma unroll
        for (int e = 0; e < 16; ++e) kv[e] *= rs * kwv[e];
        st16bf_g(kp, kv);
        *(LAS u32x4*)(KT + i * 136 + d0) = av0; *(LAS u32x4*)(KT + i * 136 + d0 + 8) = av1;
    }
    float q[16], k[16], v[16];
#pragma unroll
    for (int sec = 0; sec < 3; ++sec) {
        float acc[16];
#pragma unroll
        for (int e = 0; e < 16; ++e) acc[e] = 0.f;
        const int col = sec * 1024 + h * 128 + d0;
#pragma unroll
        for (int kk = 0; kk < 4; ++kk) {
            const int tt = t - 3 + kk;
            if (tt >= 0) { float xv[16], wv[16]; ld16bf(P + (size_t)tt * NP + col, xv); ld16f(convw + kk * 3072 + col, wv);
#pragma unroll
                for (int e = 0; e < 16; ++e) acc[e] += wv[e] * xv[e]; }
        }
#pragma unroll
        for (int e = 0; e < 16; ++e) { const float r = siluf_(acc[e]); if (sec == 0) q[e] = r; else if (sec == 1) k[e] = r; else v[e] = r; }
    }
    float sq = 0.f, sk = 0.f;
#pragma unroll
    for (int e = 0; e < 16; ++e) { sq += q[e] * q[e]; sk += k[e] * k[e]; }
    sq += __shfl_xor(sq, 1); sq += __shfl_xor(sq, 2); sq += __shfl_xor(sq, 4);
    sk += __shfl_xor(sk, 1); sk += __shfl_xor(sk, 2); sk += __shfl_xor(sk, 4);
    const float rq = rsqrtf(sq + EPS) * 0.08838834764831845f, rk = rsqrtf(sk + EPS);
#pragma unroll
    for (int e = 0; e < 16; ++e) { q[e] *= rq; k[e] *= rk; }
    if (sub == 0) { const float a = ab_a, b = ab_b; const float xx = a + dt_bias[h];
        const float sp = fmaxf(xx, 0.f) + log1pf(expf(-fabsf(xx)));
        GS[i] = -expf(A_log[h]) * sp; BS[i] = 1.0f / (1.0f + expf(-b)); }
    BAR_LDS();
    if (MODE & 1) {
#pragma unroll
        for (int q2 = 0; q2 < 2; ++q2) { const int ch = tid + 512 * q2, d = ch & 127, k8 = ch >> 7; const LAS bf16_t* vp = KT + (8 * k8) * 136 + d;
            u32x4 w; w.x = (unsigned)vp[0] | ((unsigned)vp[136] << 16); w.y = (unsigned)vp[2 * 136] | ((unsigned)vp[3 * 136] << 16);
            w.z = (unsigned)vp[4 * 136] | ((unsigned)vp[5 * 136] << 16); w.w = (unsigned)vp[6 * 136] | ((unsigned)vp[7 * 136] << 16);
            *(u32x4*)(P + (size_t)(c * 64 + (d >> 1)) * NP + P_AV + h * 128 + (d & 1) * 64 + 8 * k8) = w; }
    }
    if (wave == 0) { float g = GS[lane];
#pragma unroll
        for (int o = 1; o < 64; o <<= 1) { const float y = __shfl_up(g, o); if (lane >= o) g += y; }
        GC[lane] = g; ED[lane] = __expf(__shfl(g, 63) - g); }
    BAR_LDS();
    const float beta = BS[i], Gi = GC[i], Gl = GC[63];
    const float eg = __expf(Gi);
    float tmp[16];
    if (!(MODE & 8)) {
    st16bf_l(KT + i * 136 + d0, k);
#pragma unroll
    for (int e = 0; e < 16; ++e) tmp[e] = k[e] * beta;
    st16bf_l(KBT + i * 136 + d0, tmp);
    st16bf_l(QT + i * 136 + d0, q);
#pragma unroll
    for (int e = 0; e < 4; ++e) {
        *(LAS f32x4*)(X + i * 256 + d0 + 4 * e) = (f32x4){v[4 * e] * beta, v[4 * e + 1] * beta, v[4 * e + 2] * beta, v[4 * e + 3] * beta};
        *(LAS f32x4*)(X + i * 256 + 128 + d0 + 4 * e) = (f32x4){tmp[4 * e] * eg, tmp[4 * e + 1] * eg, tmp[4 * e + 2] * eg, tmp[4 * e + 3] * eg}; }
    }
    if (!(MODE & 16)) {
#pragma unroll
    for (int e = 0; e < 16; ++e) tmp[e] = q[e] * eg;
    const size_t pk_off = ((size_t)h * NCH + c) * 8192 + (size_t)((i >> 4) * 4 + (sub >> 1)) * 512 + (size_t)((((2 * sub) & 3) * 16 + (i & 15)) * 8);
    { u32x4 a, b; pack16(tmp, a, b); *(u32x4*)(QG + pk_off) = a; *(u32x4*)(QG + pk_off + 128) = b; }
    }
    BAR_LDS();
    if (!(MODE & 16)) {
        bf16_t* kdb = KDT + ((size_t)h * NCH + c) * 8192;
#pragma unroll
        for (int q2 = 0; q2 < 2; ++q2) { const int ch = tid + 512 * q2, d = ch & 127, i8 = ch >> 7; const LAS bf16_t* kp = KT + (8 * i8) * 136 + d; const LAS float* ep = ED + 8 * i8;
            float kv[8];
#pragma unroll
            for (int r = 0; r < 8; ++r) kv[r] = __uint_as_float((unsigned)kp[r * 136] << 16) * ep[r];
            u32x4 w; w.x = cvt_pk_bf16(kv[0], kv[1]); w.y = cvt_pk_bf16(kv[2], kv[3]); w.z = cvt_pk_bf16(kv[4], kv[5]); w.w = cvt_pk_bf16(kv[6], kv[7]);
            *(u32x4*)(kdb + (size_t)((d >> 4) * 2 + (i8 >> 2)) * 512 + (size_t)((i8 & 3) * 16 + (d & 15)) * 8) = w; }
    }
    if (MODE & 2) {
        const int fr = lane & 15, fq = lane >> 4, mt = wave >> 2, it = wave & 3;
        const LAS bf16_t* Asrc = mt ? QT : KBT;
        bf16x8 af[4];
#pragma unroll
        for (int kk = 0; kk < 4; ++kk) af[kk] = *(const LAS bf16x8*)(Asrc + (16 * it + fr) * 136 + 32 * kk + 8 * fq);
        bf16_t* aqk = AQK + ((size_t)h * NCH + c) * 4096;
        for (int jt = 0; jt < 4; ++jt) {
            f32x4 acc = {0.f, 0.f, 0.f, 0.f};
            if (jt <= it) {
#pragma unroll
                for (int kk = 0; kk < 4; ++kk) { const bf16x8 b = *(const LAS bf16x8*)(KT + (16 * jt + fr) * 136 + 32 * kk + 8 * fq); acc = MFMA16(af[kk], b, acc); }
            }
            const int j = 16 * jt + fr; const float Gj = GC[j];
#pragma unroll
            for (int r = 0; r < 4; ++r) { const int ii = 16 * it + 4 * fq + r; const float Gii = GC[ii];
                const bool keep = mt ? (ii >= j) : (ii > j);
                const float val = keep ? acc[r] * __expf(fminf(Gii - Gj, 0.f)) : 0.f;
                if (mt == 0) AS[ii * 64 + j] = val; else aqk[((ii >> 4) * 2 + (j >> 5)) * 512 + (((j >> 3) & 3) * 16 + (ii & 15)) * 8 + (j & 7)] = f2bf1(val); }
        }
    }
    BAR_LDS();
    LAS float* TB = (LAS float*)(lds + 135168);
    if ((MODE & 4) && wave == 0) {
        const int bb = lane >> 4, jc = lane & 15; const LAS float* Ab = AS + (16 * bb) * 64 + 16 * bb;
        float tc[16];
#pragma unroll
        for (int r = 0; r < 16; ++r) { float a0 = (r == jc) ? 1.f : 0.f;
#pragma unroll
            for (int m = 0; m < r; ++m) a0 -= Ab[r * 64 + m] * tc[m];
            tc[r] = a0; }
#pragma unroll
        for (int r = 0; r < 16; ++r) TB[bb * 256 + r * 16 + jc] = tc[r];
    }
    BAR_LDS();
    if (MODE & 4) {   const int fr = lane & 15, fq = lane >> 4;
        f32x4 acc[4][2];
#pragma unroll
        for (int rb = 0; rb < 4; ++rb)
#pragma unroll
            for (int q2 = 0; q2 < 2; ++q2) { const LAS float* xp = X + (16 * rb + 4 * fq) * 256 + 32 * wave + 16 * q2 + fr; acc[rb][q2] = (f32x4){xp[0], xp[256], xp[512], xp[768]}; }
#pragma unroll
        for (int bb = 0; bb < 4; ++bb) {
            const f32x4 tf = *(const LAS f32x4*)(TB + bb * 256 + fr * 16 + 4 * fq); const bf16x4 ta = mk4(tf[0], tf[1], tf[2], tf[3]);
            bf16x4 xb[2];
#pragma unroll
            for (int q2 = 0; q2 < 2; ++q2) { const bf16x4 rbf = mk4(acc[bb][q2][0], acc[bb][q2][1], acc[bb][q2][2], acc[bb][q2][3]);
                acc[bb][q2] = MFMA16K16(ta, rbf, ((f32x4){0.f, 0.f, 0.f, 0.f}));
                xb[q2] = mk4(acc[bb][q2][0], acc[bb][q2][1], acc[bb][q2][2], acc[bb][q2][3]); }
#pragma unroll
            for (int ib = bb + 1; ib < 4; ++ib) { const f32x4 af = *(const LAS f32x4*)(AS + (16 * ib + fr) * 64 + 16 * bb + 4 * fq); const bf16x4 na = mk4(-af[0], -af[1], -af[2], -af[3]);
#pragma unroll
                for (int q2 = 0; q2 < 2; ++q2) acc[ib][q2] = MFMA16K16(na, xb[q2], acc[ib][q2]); }
        }
        if (wave < 4) {
            float* up = U + ((size_t)h * NCH + c) * 8192;
#pragma unroll
            for (int rb = 0; rb < 4; ++rb)
#pragma unroll
                for (int q2 = 0; q2 < 2; ++q2) *(f32x4*)(up + (size_t)(((2 * wave + q2) * 4 + rb) * 64 + lane) * 4) = acc[rb][q2];
        } else {
            bf16_t* wp = WN + ((size_t)h * NCH + c) * 8192 + (size_t)(wave - 4) * 512 + (size_t)((fr >> 3) * 16 + 4 * fq) * 8 + (fr & 7);
#pragma unroll
            for (int rb = 0; rb < 4; ++rb)
#pragma unroll
                for (int q2 = 0; q2 < 2; ++q2)
#pragma unroll
                    for (int r = 0; r < 4; ++r) wp[(size_t)rb * 2048 + (size_t)(2 * q2 * 16 + r) * 8] = f2bf1(-acc[rb][q2][r]);
        }
        if (tid == 0) CD[h * NCH + c] = expf(Gl);
    }
    BAR_LDS();
}

__device__ __forceinline__ void gdn_scan(LAS unsigned char* lds, int h, int s, const bf16_t* WN, const bf16_t* QG, const bf16_t* KDT, const float* U, const bf16_t* AQK, const float* CD,
                                         bf16_t* Oraw, int opitch) {
    const int tid = threadIdx.x, lane = tid & 63, wave = __builtin_amdgcn_readfirstlane(tid >> 6), fr = lane & 15, fq = lane >> 4, e0 = 16 * s;
    LAS bf16_t* ST = (LAS bf16_t*)lds;
    LAS bf16_t* VT = (LAS bf16_t*)(lds + 4352);
    for (int idx = tid; idx < 16 * 136 / 2; idx += 512) ((LAS unsigned*)ST)[idx] = 0u;
    BAR_LDS();
    const bool lo = wave < 4; const int it = wave & 3;
    const bf16_t* a1p = (lo ? WN : QG) + (size_t)h * NCH * 8192 + (size_t)(it * 4) * 512 + lane * 8;
    const bf16_t* aqp = AQK + (size_t)h * NCH * 4096 + (size_t)(it * 2) * 512 + lane * 8;
    const bf16_t* kdp = KDT + (size_t)h * NCH * 8192 + (size_t)(wave * 2) * 512 + lane * 8;
    const float* up = U + (size_t)h * NCH * 8192 + (size_t)((s * 4 + it) * 64 + lane) * 4;
    bf16_t* op = Oraw + (size_t)(16 * it + 4 * fq) * opitch + h * 128 + e0 + fr;
    f32x4 S = {0.f, 0.f, 0.f, 0.f};
    constexpr int PD = 4;
    bf16x8 rA1[PD][4], rAq[PD][2], rKd[PD][2]; f32x4 rU[PD]; float rcd[PD];
#define SCAN_LOAD(st, cc) do { const size_t c_ = (size_t)(cc); \
        _Pragma("unroll") for (int kk = 0; kk < 4; ++kk) rA1[st][kk] = *(const bf16x8*)(a1p + c_ * 8192 + 512 * kk); \
        _Pragma("unroll") for (int kk = 0; kk < 2; ++kk) rKd[st][kk] = *(const bf16x8*)(kdp + c_ * 8192 + 512 * kk); \
        if (lo) rU[st] = *(const f32x4*)(up + c_ * 8192); \
        else { _Pragma("unroll") for (int kk = 0; kk < 2; ++kk) rAq[st][kk] = *(const bf16x8*)(aqp + c_ * 4096 + 512 * kk); } \
        rcd[st] = CD[h * NCH + (cc)]; } while (0)
#pragma unroll
    for (int st = 0; st < PD; ++st) { rU[st] = (f32x4){0.f, 0.f, 0.f, 0.f}; rAq[st][0] = rAq[st][1] = (bf16x8){0, 0, 0, 0, 0, 0, 0, 0}; SCAN_LOAD(st, st); }
#pragma unroll 8
    for (int c0 = 0; c0 < NCH; c0 += PD) {
#pragma unroll
        for (int st = 0; st < PD; ++st) {
            const int c = c0 + st;
            f32x4 acc = rU[st];
#pragma unroll
            for (int kk = 0; kk < 4; ++kk) { const bf16x8 sb = *(const LAS bf16x8*)(ST + fr * 136 + 32 * kk + 8 * fq); acc = MFMA16(rA1[st][kk], sb, acc); }
            if (lo) { u32x2 w; w.x = cvt_pk_bf16(acc[0], acc[1]); w.y = cvt_pk_bf16(acc[2], acc[3]); *(LAS u32x2*)(VT + fr * 72 + 16 * it + 4 * fq) = w; }
            BAR_LDS();
            bf16x8 vb[2];
#pragma unroll
            for (int kk = 0; kk < 2; ++kk) vb[kk] = *(const LAS bf16x8*)(VT + fr * 72 + 32 * kk + 8 * fq);
            if (!lo) {
#pragma unroll
                for (int kk = 0; kk < 2; ++kk) acc = MFMA16(rAq[st][kk], vb[kk], acc);
#pragma unroll
                for (int r = 0; r < 4; ++r) op[((size_t)c * 64 + r) * opitch] = f2bf1(acc[r]);
            }
            S = S * rcd[st];
#pragma unroll
            for (int kk = 0; kk < 2; ++kk) S = MFMA16(rKd[st][kk], vb[kk], S);
            { u32x2 w; w.x = cvt_pk_bf16(S[0], S[1]); w.y = cvt_pk_bf16(S[2], S[3]); *(LAS u32x2*)(ST + fr * 136 + 16 * wave + 4 * fq) = w; }
            if (c + PD < NCH) SCAN_LOAD(st, c + PD);
            BAR_LDS();
        }
    }
#undef SCAN_LOAD
}

__device__ __forceinline__ void attn_unit(LAS unsigned char* lds, int n, int h, const bf16_t* P, const float* qw, const float* relb, float shift, bf16_t* OA) {
    const int tid = threadIdx.x, lane = tid & 63, wave = __builtin_amdgcn_readfirstlane(tid >> 6), fr = lane & 15, fq = lane >> 4, it = wave >> 1, kh = wave & 1;
    LAS bf16_t* KS = (LAS bf16_t*)lds; LAS bf16_t* VTS = (LAS bf16_t*)(lds + 17408); LAS float* BIAS = (LAS float*)(lds + 34816);
    for (int idx = tid; idx < 320; idx += 512) BIAS[idx] = relb[h * 320 + idx] * L2E;
    bf16x8 qf[4];
    {   const bf16_t* qp = P + (size_t)(n * 64 + 16 * it + fr) * NP + P_AQ + h * 128 + 8 * fq;
        float qv[4][8]; float ss = 0.f;
#pragma unroll
        for (int kk = 0; kk < 4; ++kk) { const u32x4 a = *(const u32x4*)(qp + 32 * kk);
            qv[kk][0] = bf_lo(a.x); qv[kk][1] = bf_hi(a.x); qv[kk][2] = bf_lo(a.y); qv[kk][3] = bf_hi(a.y); qv[kk][4] = bf_lo(a.z); qv[kk][5] = bf_hi(a.z); qv[kk][6] = bf_lo(a.w); qv[kk][7] = bf_hi(a.w);
#pragma unroll
            for (int e = 0; e < 8; ++e) ss += qv[kk][e] * qv[kk][e]; }
        ss += __shfl_xor(ss, 16); ss += __shfl_xor(ss, 32);
        const float rs = rsqrtf(ss * (1.0f / 128.0f) + EPS) * (0.08838834764831845f * L2E);
#pragma unroll
        for (int kk = 0; kk < 4; ++kk) { const float* wp = qw + 32 * kk + 8 * fq; const f32x4 w0 = *(const f32x4*)wp, w1 = *(const f32x4*)(wp + 4);
            qf[kk] = mk8(cvt_pk_bf16(qv[kk][0] * rs * w0[0], qv[kk][1] * rs * w0[1]), cvt_pk_bf16(qv[kk][2] * rs * w0[2], qv[kk][3] * rs * w0[3]),
                         cvt_pk_bf16(qv[kk][4] * rs * w1[0], qv[kk][5] * rs * w1[1]), cvt_pk_bf16(qv[kk][6] * rs * w1[2], qv[kk][7] * rs * w1[3])); }
    }
    const int kt_lo = (n >= 8) ? 0 : 8 - n;
    const int key = tid >> 3, sub = tid & 7, vd = tid >> 2, vpart = tid & 3;
    u32x4 nk0, nk1, nv0, nv1;
#define ATT_LOAD(kt_) do { const bf16_t* rp = P + (size_t)((n - 8 + (kt_)) * 64 + key) * NP + h * 128 + 16 * sub + P_AK; \
        const bf16_t* vq = P + (size_t)((n - 8 + (kt_)) * 64 + (vd >> 1)) * NP + P_AV + h * 128 + (vd & 1) * 64 + 16 * vpart; \
        nk0 = *(const u32x4*)(rp); nk1 = *(const u32x4*)(rp + 8); nv0 = *(const u32x4*)(vq); nv1 = *(const u32x4*)(vq + 8); } while (0)
    ATT_LOAD(kt_lo);
    f32x4 oacc[8];
#pragma unroll
    for (int dt = 0; dt < 8; ++dt) oacc[dt] = (f32x4){0.f, 0.f, 0.f, 0.f};
    float lsum = 0.f;
    for (int kt = kt_lo; kt < 9; ++kt) {
        {   *(LAS u32x4*)(KS + key * 136 + 16 * sub) = nk0; *(LAS u32x4*)(KS + key * 136 + 16 * sub + 8) = nk1;
            LAS bf16_t* vrow = VTS + vd * 68; const int dtw = vd >> 4, g0 = 4 * vpart;
            *(LAS u32x2*)(vrow + (((g0 + 0) ^ dtw) << 2)) = (u32x2){nv0.x, nv0.y}; *(LAS u32x2*)(vrow + (((g0 + 1) ^ dtw) << 2)) = (u32x2){nv0.z, nv0.w};
            *(LAS u32x2*)(vrow + (((g0 + 2) ^ dtw) << 2)) = (u32x2){nv1.x, nv1.y}; *(LAS u32x2*)(vrow + (((g0 + 3) ^ dtw) << 2)) = (u32x2){nv1.z, nv1.w};
        }
        BAR_LDS();
        if (kt + 1 < 9) ATT_LOAD(kt + 1);
        unsigned pk[2][2];
#pragma unroll
        for (int kt2 = 0; kt2 < 2; ++kt2) { const int kb = 32 * kh + 16 * kt2; f32x4 acc = {0.f, 0.f, 0.f, 0.f};
#pragma unroll
            for (int kk = 0; kk < 4; ++kk) { const bf16x8 a = *(const LAS bf16x8*)(KS + (kb + fr) * 136 + 32 * kk + 8 * fq); acc = MFMA16(a, qf[kk], acc); }
            float p[4];
#pragma unroll
            for (int r = 0; r < 4; ++r) { const int jband = 64 * kt + kb + 4 * fq + r; int rel = (16 * it + fr) - jband + 512; rel = rel < -63 ? -63 : (rel > 256 ? 256 : rel);
                p[r] = __builtin_amdgcn_exp2f(acc[r] + BIAS[rel + 63] - shift); lsum += p[r]; }
            pk[kt2][0] = cvt_pk_bf16(p[0], p[1]); pk[kt2][1] = cvt_pk_bf16(p[2], p[3]); }
        const bf16x8 pf = mk8(pk[0][0], pk[0][1], pk[1][0], pk[1][1]);
#pragma unroll
        for (int dt = 0; dt < 8; ++dt) { const LAS bf16_t* vrow = VTS + (16 * dt + fr) * 68; const int g0 = 8 * kh + fq;
            const u32x2 a0 = *(const LAS u32x2*)(vrow + (((g0) ^ dt) << 2)), a1 = *(const LAS u32x2*)(vrow + (((g0 + 4) ^ dt) << 2));
            oacc[dt] = MFMA16(mk8(a0.x, a0.y, a1.x, a1.y), pf, oacc[dt]); }
        BAR_LDS();
    }
#undef ATT_LOAD
    lsum += __shfl_xor(lsum, 16); lsum += __shfl_xor(lsum, 32);
    LAS float* CB = (LAS float*)lds;
    if (kh == 1) {
#pragma unroll
        for (int dt = 0; dt < 8; ++dt)
#pragma unroll
            for (int r = 0; r < 4; ++r) CB[(it * 33 + dt * 4 + r) * 64 + lane] = oacc[dt][r];
        CB[(it * 33 + 32) * 64 + lane] = lsum; }
    BAR_LDS();
    if (kh == 0) {
#pragma unroll
        for (int dt = 0; dt < 8; ++dt)
#pragma unroll
            for (int r = 0; r < 4; ++r) oacc[dt][r] += CB[(it * 33 + dt * 4 + r) * 64 + lane];
        lsum += CB[(it * 33 + 32) * 64 + lane];
        const float inv = 1.0f / lsum;
        bf16_t* op = OA + (size_t)(n * 64 + 16 * it + fr) * 1024 + h * 128 + 4 * fq;
#pragma unroll
        for (int dt = 0; dt < 8; ++dt) { u32x2 w; w.x = cvt_pk_bf16(oacc[dt][0] * inv, oacc[dt][1] * inv); w.y = cvt_pk_bf16(oacc[dt][2] * inv, oacc[dt][3] * inv); *(u32x2*)(op + 16 * dt) = w; }
    }
    BAR_LDS();
}
struct Args { const float* in[21]; float* out; unsigned char* ws; int ph_lo, ph_hi; };
constexpr int NPHASE = 11;
__global__ void __launch_bounds__(512, 2) hybrid_fwd(Args args) {
    extern __shared__ __attribute__((aligned(16))) unsigned char lds_raw[];
    LAS unsigned char* lds = (LAS unsigned char*)lds_raw;
    if (threadIdx.x < 16) ((LAS unsigned*)(lds + LDS_BYTES - 64))[threadIdx.x] = 0u;
    __syncthreads();
    XcdBarrier bar; bar.bar = nullptr; bar.x = 0; bar.st = nullptr;
    if (args.ph_hi - args.ph_lo > 1) bar = xcd_barrier_post((unsigned*)(args.ws + WS_BAR), (volatile LAS unsigned*)(lds + LDS_BYTES - 64));
    const int tid = threadIdx.x, lane = tid & 63, wave = __builtin_amdgcn_readfirstlane(tid >> 6);
    const int G = gridDim.x, bx = blockIdx.x;
    unsigned char* ws = args.ws; float* ctl = (float*)(ws + WS_CTL);
    bf16_t* XB = (bf16_t*)(ws + WS_XB); bf16_t* Pb = (bf16_t*)(ws + WS_P);
    float* xres = args.out;
    const int lo = args.ph_lo, hi = args.ph_hi;
#define IN(k) (lo <= (k) && (k) < hi)
#ifndef DUP_MASK
#define DUP_MASK 0
#endif
#define REP(k) for (int rep_ = 0; rep_ < (((DUP_MASK >> (k)) & 1) ? 2 : 1); ++rep_)
#define REPBAR() do { if (rep_) xcd_barrier(bar); } while (0)
#define SEAM(k) do { if (IN(k) && IN((k) + 1)) xcd_barrier(bar); } while (0)

    Ptrs A; for (int i = 0; i < 21; ++i) A.in[i] = args.in[i]; A.out = args.out; A.ws = ws;
    if (IN(0)) REP(0) { REPBAR(); p0_prologue(A, lds, bx, G); }
    SEAM(0);
    if (IN(1)) REP(1) { REPBAR();
        pg8::Gemm g{XB, (const bf16_t*)(ws + WS_WGU1), T, NGU, D}; pg8::StaticOrder S; S.init(T, NGU, G, bx);
        pg8::EpiSwiglu E{(bf16_t*)(ws + WS_ACT1), FF, ctl + CW_SS1};
        pg8::gemm_phase<pg8::EpiSwiglu, pg8::StaticOrder, true, true>(lds, g, S, E);
        if (LATE_CVT && bx >= 96 && G == 256) cvt_items<true>(A, lds, (bx - 96) * 8 + wave, 160 * 8, N_EARLY, N_EARLY + N_LATE1);
    }
    SEAM(1);
    if (IN(2)) {
        pg8::Gemm g{(const bf16_t*)(ws + WS_ACT1), (const bf16_t*)(ws + WS_WD1), T, D, FF}; pg8::StaticOrder S; S.init(T, D, G, bx);
        pg8::EpiResid<true> E{args.in[0], xres, XB, ctl + CW_SS2, 0.5f};
        pg8::gemm_phase<pg8::EpiResid<true>, pg8::StaticOrder, false, true>(lds, g, S, E);
    }
    SEAM(2);
    if (IN(3)) REP(3) { REPBAR();
        pg8::Gemm g{XB, (const bf16_t*)(ws + WS_WIN), T, NINP, D}; pg8::StaticOrder S; S.init(T, NINP, G, bx);
        pg8::EpiP E{Pb, ctl + CW_AB, ctl + CW_SS2};
        pg8::gemm_phase<pg8::EpiP, pg8::StaticOrder, true, true>(lds, g, S, E);
        if (LATE_CVT && G == 256) { if (bx >= 160) cvt_items<true>(A, lds, (bx - 160) * 8 + wave, 96 * 8, N_EARLY + N_LATE1, NITEMS); }
        else if (LATE_CVT) cvt_items(A, lds, bx * 8 + wave, G * 8, N_EARLY, NITEMS);
    }
    SEAM(3);
#ifndef DBG_SKIP_GDN
    if (IN(4)) {
#ifdef PROBE_P4_MODE
        for (int u = bx; u < NCH * H; u += G)
            gdn_prep_unit<PROBE_P4_MODE>(lds, u >> 3, u & 7, Pb, ctl + CW_AB, args.in[7], args.in[8], args.in[9], args.in[12], (bf16_t*)(ws + WS_WN), (bf16_t*)(ws + WS_QG), (bf16_t*)(ws + WS_KDT),
                          (float*)(ws + WS_U), (bf16_t*)(ws + WS_AQK), ctl + CW_CD);
        xcd_barrier(bar);
#endif
        for (int u = bx; u < NCH * H; u += G)
            gdn_prep_unit(lds, u >> 3, u & 7, Pb, ctl + CW_AB, args.in[7], args.in[8], args.in[9], args.in[12], (bf16_t*)(ws + WS_WN), (bf16_t*)(ws + WS_QG), (bf16_t*)(ws + WS_KDT),
                          (float*)(ws + WS_U), (bf16_t*)(ws + WS_AQK), ctl + CW_CD);
    }
#endif
    SEAM(4);
#define P5_BODY(part_, late_) do { \
        if (bx < 64) { if ((part_) & 1) gdn_scan(lds, bx & 7, bx >> 3, (const bf16_t*)(ws + WS_WN), (const bf16_t*)(ws + WS_QG), (const bf16_t*)(ws + WS_KDT), (const float*)(ws + WS_U), (const bf16_t*)(ws + WS_AQK), \
                              ctl + CW_CD, (bf16_t*)(ws + WS_ORAW), 1024); \
            } \
        else if ((part_) & 2) { const float shift = ctl[CW_SHIFT]; \
            for (int u = bx - 64; u < NCH * H; u += G - 64) attn_unit(lds, u >> 3, u & 7, Pb, args.in[11], args.in[13], shift, (bf16_t*)(ws + WS_OA)); } } while (0)
    if (IN(5)) {
        P5_BODY(3, 1);
#ifdef PROBE_P5_PART
        xcd_barrier(bar); P5_BODY(PROBE_P5_PART, 0);
#endif
    }
    SEAM(5);
    if (IN(6)) REP(6) { REPBAR();
        const int gw = bx * 8 + wave, NGW = G * 8; const int hh = lane >> 3, d0 = (lane & 7) * 16;
        float wv[16]; ld16f(args.in[10] + d0, wv);
        bf16_t* OG = (bf16_t*)(ws + WS_OG);
        for (int row = gw; row < T; row += NGW) {
            float o[16], z[16];
#ifdef DBG_GDN_U
            ld16f((const float*)(ws + WS_U) + (size_t)row * 1024 + hh * 128 + d0, o);
#else
            ld16bf((const bf16_t*)(ws + WS_ORAW) + (size_t)row * 1024 + hh * 128 + d0, o);
#endif
            ld16bf(Pb + (size_t)row * NP + P_GZ + hh * 128 + d0, z);
            float ss = 0.f;
#pragma unroll
            for (int e = 0; e < 16; ++e) ss += o[e] * o[e];
            ss += __shfl_xor(ss, 1); ss += __shfl_xor(ss, 2); ss += __shfl_xor(ss, 4);
            const float rs = rsqrtf(ss * (1.0f / 128.0f) + EPS);
#pragma unroll
            for (int e = 0; e < 16; ++e) o[e] = o[e] * rs * wv[e] * siluf_(z[e]);
#ifdef DBG_SKIP_GDN
            for (int e = 0; e < 16; ++e) o[e] = 0.f;
#endif
            st16bf_g(OG + (size_t)row * 1024 + hh * 128 + d0, o);
        }
    }
    SEAM(6);
    if (IN(7)) REP(7) { REPBAR();
        bf16_t* Mb = (bf16_t*)(ws + WS_M);
        { pg8::Gemm g{(const bf16_t*)(ws + WS_OG), (const bf16_t*)(ws + WS_WA), T, D, 1024}; pg8::StaticOrder S; S.init(T, D, G, bx);
          pg8::EpiGate<0> E{Mb, Pb, P_G1}; pg8::gemm_phase<pg8::EpiGate<0>, pg8::StaticOrder, false, true>(lds, g, S, E); }
        { pg8::Gemm g{(const bf16_t*)(ws + WS_OA), (const bf16_t*)(ws + WS_WB), T, D, 1024}; pg8::StaticOrder S; S.init(T, D, G, bx);
          pg8::EpiGate<1> E{Mb, Pb, P_G2}; pg8::gemm_phase<pg8::EpiGate<1>, pg8::StaticOrder, false, true>(lds, g, S, E); }
    }
    SEAM(7);
    if (IN(8)) {
        pg8::Gemm g{(const bf16_t*)(ws + WS_M), (const bf16_t*)(ws + WS_WOUT), T, D, D}; pg8::StaticOrder S; S.init(T, D, G, bx);
        pg8::EpiResid<true> E{xres, xres, XB, ctl + CW_SS3, 1.0f};
        pg8::gemm_phase<pg8::EpiResid<true>, pg8::StaticOrder, false, true>(lds, g, S, E);
    }
    SEAM(8);
    if (IN(9)) REP(9) { REPBAR();
        pg8::Gemm g{XB, (const bf16_t*)(ws + WS_WGU2), T, NGU, D}; pg8::StaticOrder S; S.init(T, NGU, G, bx);
        pg8::EpiSwiglu E{(bf16_t*)(ws + WS_ACT2), FF, ctl + CW_SS3};
        pg8::gemm_phase<pg8::EpiSwiglu, pg8::StaticOrder, true, true>(lds, g, S, E);
    }
    SEAM(9);
    if (IN(10)) {
        pg8::Gemm g{(const bf16_t*)(ws + WS_ACT2), (const bf16_t*)(ws + WS_WD2), T, D, FF}; pg8::StaticOrder S; S.init(T, D, G, bx);
        pg8::EpiResid<false> E{xres, xres, nullptr, nullptr, 0.5f};
        pg8::gemm_phase<pg8::EpiResid<false>, pg8::StaticOrder, false, true>(lds, g, S, E);
    }
#undef IN
#undef SEAM
}

extern "C" void kernel_launch(void* const* d_in, const int* in_sizes, int n_in, void* d_out, int out_size, void* d_ws, size_t ws_size, hipStream_t stream) {
    static int grid = 0;
    if (grid == 0) {
        if (n_in != 21 || out_size != T * D || ws_size < WS_END) { fprintf(stderr, "kernel_launch: unexpected problem (n_in %d, out %d, ws %zu)\n", n_in, out_size, ws_size); grid = -1; return; }
        int dev = 0, cus = 0, per_cu = 0;
        if (hipGetDevice(&dev) != hipSuccess || hipDeviceGetAttribute(&cus, hipDeviceAttributeMultiprocessorCount, dev) != hipSuccess) { grid = -1; return; }
        if (hipFuncSetAttribute((const void*)hybrid_fwd, hipFuncAttributeMaxDynamicSharedMemorySize, LDS_BYTES) != hipSuccess) { fprintf(stderr, "kernel_launch: hipFuncSetAttribute failed\n"); grid = -1; return; }
        if (hipOccupancyMaxActiveBlocksPerMultiprocessor(&per_cu, (const void*)hybrid_fwd, 512, LDS_BYTES) != hipSuccess || per_cu < 1) { fprintf(stderr, "kernel_launch: occupancy query says %d\n", per_cu); per_cu = 1; }
        (void)hipGetLastError();
        grid = cus;
    }
    if (grid < 0) return;
    if (hipMemsetAsync((char*)d_ws + WS_BAR, 0, 16384, stream) != hipSuccess) { fprintf(stderr, "kernel_launch: hipMemsetAsync failed\n"); return; }
    Args a{};
    for (int i = 0; i < 21; ++i) a.in[i] = (const float*)d_in[i];
    a.out = (float*)d_out; a.ws = (unsigned char*)d_ws;
#if N_LAUNCH == 1
    a.ph_lo = 0; a.ph_hi = NPHASE;
    void* kargs[] = {&a};
    hipError_t e = hipLaunchCooperativeKernel((const void*)hybrid_fwd, dim3(grid), dim3(512), kargs, LDS_BYTES, stream);
    if (e != hipSuccess) fprintf(stderr, "cooperative launch failed: %s (grid %d)\n", hipGetErrorString(e), grid);
#else
    for (int ph = 0; ph < NPHASE; ++ph) { a.ph_lo = ph; a.ph_hi = ph + 1; hipLaunchKernelGGL(hybrid_fwd, dim3(grid), dim3(512), LDS_BYTES, stream, a); }
#endif
}
```

```cpp
#include <hip/hip_runtime.h>
#include <hip/hip_cooperative_groups.h>
#include <cstdio>
#include <cstdint>
namespace cg = cooperative_groups;
namespace pg8 {
#define PG8_LAS __attribute__((address_space(3)))
typedef unsigned short bf16_t;
typedef short bf16x8 __attribute__((ext_vector_type(8)));
typedef float f32x4 __attribute__((ext_vector_type(4)));
typedef unsigned u32x4 __attribute__((ext_vector_type(4)));
constexpr int BM = 256, BK = 64, HALF = 128, HTB = HALF * BK * 2  , STAGE_BYTES = 8 * HTB, NXCD = 8, WGM = 8;

__host__ __device__ __forceinline__ int lds_byte(int r, int c) { const int st = (r >> 4) * 2 + (c >> 5), rr = r & 15, cc = c & 31, ob = rr * 64 + cc * 2; return st * 1024 + (ob ^ (((ob >> 9) & 1) << 5)); }
__host__ __device__ __forceinline__ void stage_rc(int b, int& R, int& C) { const int st = b / 1024, sb = b % 1024, swz = sb ^ (((sb >> 9) & 1) << 5); R = (st >> 1) * 16 + swz / 64; C = (st & 1) * 32 + (swz % 64) / 2; }
__host__ __device__ __forceinline__ int perm32(int rho) { const int n = rho >> 4, i = rho & 15; return 8 * (i >> 2) + 4 * n + (i & 3); }

struct Unit { int pm, pn; };
struct Gemm { const bf16_t* A; const bf16_t* Bt; int M, N, K; };

struct StaticOrder {
    int nM, nN, nwg, G, c;
    __host__ __device__ void init(int M, int N, int G_, int c_) { nM = M / BM; nN = N / BM; nwg = nM * nN; G = G_; c = c_; }
    __host__ __device__ bool next(int i, Unit& u) const {
        const long L = (long)i * G + c; if (L >= nwg) return false;
        int wgid = (int)L; { const int q = nwg / NXCD, r = nwg % NXCD, xcd = wgid % NXCD, off = wgid / NXCD; wgid = (xcd < r ? xcd * (q + 1) : r * (q + 1) + (xcd - r) * q) + off; }
        const int nig = WGM * nN, gid = wgid / nig, fm = gid * WGM, gsz = (nM - fm) < WGM ? (nM - fm) : WGM;
        u.pm = fm + ((wgid % nig) % gsz); u.pn = (wgid % nig) / gsz; return true;
    }
    __device__ __forceinline__ void a_ready(const Unit&) const {}
    __device__ __forceinline__ void done(const Unit&) const {}
};
typedef unsigned u32x2 __attribute__((ext_vector_type(2)));

typedef float f32x2_t __attribute__((ext_vector_type(2))); typedef __bf16 bf16x2_t __attribute__((ext_vector_type(2)));
__device__ __forceinline__ unsigned cvt_pk_bf16(float lo, float hi) { const f32x2_t v = {lo, hi}; const bf16x2_t b = __builtin_convertvector(v, bf16x2_t); return __builtin_bit_cast(unsigned, b); }
__device__ __forceinline__ float bf_lo(unsigned u) { return __uint_as_float(u << 16); }
__device__ __forceinline__ float bf_hi(unsigned u) { return __uint_as_float(u & 0xffff0000u); }
__device__ __forceinline__ float sigmoidf_(float x) { return __builtin_amdgcn_rcpf(1.0f + __expf(-x)); }
__device__ __forceinline__ float siluf_(float x) { return x * sigmoidf_(x); }
constexpr float NORM_EPS = 1e-6f;
constexpr int DM = 2048;
constexpr int NP = 11328;

typedef float f32x2 __attribute__((ext_vector_type(2)));
__device__ __forceinline__ f32x2 swiglu_pk(f32x2 g, f32x2 u, float rs) {
    const f32x2 gs = g * rs, us = u * rs, t = gs * (-1.4426950408889634f);
    f32x2 e; e.x = __builtin_amdgcn_exp2f(t.x); e.y = __builtin_amdgcn_exp2f(t.y);
    const f32x2 d = e + 1.0f;
    f32x2 r; r.x = __builtin_amdgcn_rcpf(d.x); r.y = __builtin_amdgcn_rcpf(d.y);
    return (gs * r) * us;
}
struct EpiSwiglu {
    static constexpr bool PERM = true, AFTER_DRAIN = false;
    bf16_t* O; int ldc; const float* rowss;
    __device__ __forceinline__ void operator()(const f32x4 (&acc)[2][2][4][2], const Unit& u, int wr, int wc, int fr, int fq) const {
        const int row0 = u.pm * BM + wr * 64 + fr; const int col0 = u.pn * 128 + wc * 32 + 8 * fq;
#pragma unroll
        for (int ai = 0; ai < 2; ++ai)
#pragma unroll
            for (int m = 0; m < 4; ++m) { const int row = row0 + ai * HALF + m * 16; const float rs = rsqrtf(rowss[row] * (1.0f / DM) + NORM_EPS);
                const f32x4 g0 = acc[ai][0][m][0], g1 = acc[ai][0][m][1], u0 = acc[ai][1][m][0], u1 = acc[ai][1][m][1];
                const f32x2 a = swiglu_pk((f32x2){g0[0], g0[1]}, (f32x2){u0[0], u0[1]}, rs), b = swiglu_pk((f32x2){g0[2], g0[3]}, (f32x2){u0[2], u0[3]}, rs);
                const f32x2 c = swiglu_pk((f32x2){g1[0], g1[1]}, (f32x2){u1[0], u1[1]}, rs), d = swiglu_pk((f32x2){g1[2], g1[3]}, (f32x2){u1[2], u1[3]}, rs);
                u32x4 w; w.x = cvt_pk_bf16(a.x, a.y); w.y = cvt_pk_bf16(b.x, b.y); w.z = cvt_pk_bf16(c.x, c.y); w.w = cvt_pk_bf16(d.x, d.y);
                *(u32x4*)(O + (size_t)row * ldc + col0) = w; }
    }
};
struct EpiP {
    static constexpr bool PERM = true, AFTER_DRAIN = false;
    bf16_t* P; float* AB; const float* rowss;
    __device__ __forceinline__ void operator()(const f32x4 (&acc)[2][2][4][2], const Unit& u, int wr, int wc, int fr, int fq) const {
        const int row0 = u.pm * BM + wr * 64 + fr;
        if (u.pn < 44) { const int col0 = u.pn * BM + wc * 32 + 8 * fq;
#pragma unroll
            for (int ai = 0; ai < 2; ++ai)
#pragma unroll
                for (int m = 0; m < 4; ++m) { const int row = row0 + ai * HALF + m * 16; const float rs = rsqrtf(rowss[row] * (1.0f / DM) + NORM_EPS);
#pragma unroll
                    for (int bj = 0; bj < 2; ++bj) { const f32x4 v0 = acc[ai][bj][m][0] * rs, v1 = acc[ai][bj][m][1] * rs;
                        u32x4 w; w.x = cvt_pk_bf16(v0[0], v0[1]); w.y = cvt_pk_bf16(v0[2], v0[3]); w.z = cvt_pk_bf16(v1[0], v1[1]); w.w = cvt_pk_bf16(v1[2], v1[3]);
                        *(u32x4*)(P + (size_t)row * NP + col0 + bj * HALF) = w; } }
        } else if (wc == 0 && fq < 2) {
#pragma unroll
            for (int ai = 0; ai < 2; ++ai)
#pragma unroll
                for (int m = 0; m < 4; ++m) { const int row = row0 + ai * HALF + m * 16; const float rs = rsqrtf(rowss[row] * (1.0f / DM) + NORM_EPS);
                    *(f32x4*)(AB + (size_t)row * 16 + 8 * fq) = acc[ai][0][m][0] * rs; *(f32x4*)(AB + (size_t)row * 16 + 8 * fq + 4) = acc[ai][0][m][1] * rs; }
        }
    }
};
template <int WHICH> struct EpiGate {
    static constexpr bool PERM = true, AFTER_DRAIN = false;
    bf16_t* Mo; const bf16_t* P; int goff;
    __device__ __forceinline__ void operator()(const f32x4 (&acc)[2][2][4][2], const Unit& u, int wr, int wc, int fr, int fq) const {
        const int row0 = u.pm * BM + wr * 64 + fr; const int col0 = u.pn * BM + wc * 32 + 8 * fq;
#pragma unroll
        for (int ai = 0; ai < 2; ++ai)
#pragma unroll
            for (int m = 0; m < 4; ++m) { const int row = row0 + ai * HALF + m * 16;
#pragma unroll
                for (int bj = 0; bj < 2; ++bj) { const int col = col0 + bj * HALF;
                    const u32x4 g = *(const u32x4*)(P + (size_t)row * NP + goff + col);
                    const f32x4 a0 = acc[ai][bj][m][0], a1 = acc[ai][bj][m][1];
                    float v[8];
                    v[0] = sigmoidf_(bf_lo(g.x)) * a0[0]; v[1] = sigmoidf_(bf_hi(g.x)) * a0[1]; v[2] = sigmoidf_(bf_lo(g.y)) * a0[2]; v[3] = sigmoidf_(bf_hi(g.y)) * a0[3];
                    v[4] = sigmoidf_(bf_lo(g.z)) * a1[0]; v[5] = sigmoidf_(bf_hi(g.z)) * a1[1]; v[6] = sigmoidf_(bf_lo(g.w)) * a1[2]; v[7] = sigmoidf_(bf_hi(g.w)) * a1[3];
                    bf16_t* op = Mo + (size_t)row * DM + col;
                    if (WHICH == 1) { const u32x4 o = *(const u32x4*)op;
                        v[0] += bf_lo(o.x); v[1] += bf_hi(o.x); v[2] += bf_lo(o.y); v[3] += bf_hi(o.y); v[4] += bf_lo(o.z); v[5] += bf_hi(o.z); v[6] += bf_lo(o.w); v[7] += bf_hi(o.w); }
                    u32x4 w; w.x = cvt_pk_bf16(v[0], v[1]); w.y = cvt_pk_bf16(v[2], v[3]); w.z = cvt_pk_bf16(v[4], v[5]); w.w = cvt_pk_bf16(v[6], v[7]);
                    *(u32x4*)op = w; } }
    }
};
template <bool BF> struct EpiResid {
    static constexpr bool PERM = false, AFTER_DRAIN = false;
    const float* R; float* out; bf16_t* XB; float* rowss; float scale;
    __device__ __forceinline__ void operator()(const f32x4 (&acc)[2][2][4][2], const Unit& u, int wr, int wc, int fr, int fq) const {
        const int row0 = u.pm * BM + wr * 64 + fr; const int col0 = u.pn * BM + wc * 32 + 4 * fq;
#pragma unroll
        for (int ai = 0; ai < 2; ++ai)
#pragma unroll
            for (int m = 0; m < 4; ++m) { const int row = row0 + ai * HALF + m * 16; float ss = 0.f;
#pragma unroll
                for (int bj = 0; bj < 2; ++bj)
#pragma unroll
                    for (int n = 0; n < 2; ++n) { const size_t off = (size_t)row * DM + col0 + bj * HALF + n * 16;
                        const f32x4 r = *(const f32x4*)(R + off); const f32x4 y = r + acc[ai][bj][m][n] * scale;
                        *(f32x4*)(out + off) = y;
                        if (BF) { u32x2 w; w.x = cvt_pk_bf16(y[0], y[1]); w.y = cvt_pk_bf16(y[2], y[3]); *(u32x2*)(XB + off) = w; ss += (y[0] * y[0] + y[1] * y[1]) + (y[2] * y[2] + y[3] * y[3]); } }
                if (BF) { ss += __shfl_xor(ss, 16); ss += __shfl_xor(ss, 32); if (fq == 0) atomicAdd(rowss + row, ss); } }
    }
};

template <class Epi, class Sched, bool ALIGN_EPI = false, bool SP2 = false>
__device__ __forceinline__ void gemm_phase(PG8_LAS unsigned char* lds, const Gemm g, const Sched& S, const Epi& E) {
    const int tid = threadIdx.x, wid = __builtin_amdgcn_readfirstlane(tid >> 6), lane = tid & 63, wr = wid >> 2, wc = wid & 3, fr = lane & 15, fq = lane >> 4;
    const int K = g.K, nt = K / BK;
    unsigned voffA[2], voffB[2];
#pragma unroll
    for (int i = 0; i < 2; ++i) { int R, C; stage_rc(tid * 16 + i * 8192, R, C); const int Rb = Epi::PERM ? ((R & ~31) + perm32(R & 31)) : R;
        voffA[i] = (unsigned)(R * K + C) * 2u; voffB[i] = (unsigned)(Rb * K + C) * 2u; }
    const size_t kstep = (size_t)(BK * 2);
    const size_t hstep = (size_t)HALF * K * 2;
    const size_t tstep = 2 * hstep;
    const unsigned ldsw = (unsigned)wid * 1024u;
    const int aoff = lds_byte(wr * 64 + fr, fq * 8), boff = lds_byte(wc * 32 + fr, fq * 8);
#define PG8_SA(b, h) (((b) * 2 + (h)) * HTB)
#define PG8_SB(b, h) ((4 + (b) * 2 + (h)) * HTB)
#define PG8_STAGE(bufoff, gbase, voff) do { _Pragma("unroll") for (int _i = 0; _i < 2; ++_i) \
        __builtin_amdgcn_global_load_lds((const unsigned*)((const char*)(gbase) + (voff)[_i]), (PG8_LAS unsigned*)(lds + (bufoff) + ldsw + _i * 8192), 16, 0, 0); } while (0)
#define PG8_LDA(dst, b, h) do { _Pragma("unroll") for (int m = 0; m < 4; ++m) _Pragma("unroll") for (int k = 0; k < 2; ++k) dst[m][k] = *(const PG8_LAS bf16x8*)(lds + PG8_SA(b, h) + aoff + m * 2048 + k * 1024); } while (0)
#define PG8_LDB(dst, b, h) do { _Pragma("unroll") for (int n = 0; n < 2; ++n) _Pragma("unroll") for (int k = 0; k < 2; ++k) dst[n][k] = *(const PG8_LAS bf16x8*)(lds + PG8_SB(b, h) + boff + n * 2048 + k * 1024); } while (0)
#define PG8_MMA(ai, bj, At, Bt) do { __builtin_amdgcn_s_setprio(1); _Pragma("unroll") for (int m = 0; m < 4; ++m) _Pragma("unroll") for (int n = 0; n < 2; ++n) _Pragma("unroll") for (int k = 0; k < 2; ++k) \
        acc[ai][bj][m][n] = __builtin_amdgcn_mfma_f32_16x16x32_bf16(Bt[n][k], At[m][k], acc[ai][bj][m][n], 0, 0, 0); __builtin_amdgcn_s_setprio(0); } while (0)
#define PG8_WAIT_V(n) asm volatile("s_waitcnt vmcnt(" #n ")" ::: "memory")
#define PG8_WAIT_L(n) asm volatile("s_waitcnt lgkmcnt(" #n ")" ::: "memory")
#define PG8_BAR __builtin_amdgcn_s_barrier()
#define PG8_SCHED __builtin_amdgcn_sched_barrier(0)
    Unit cur, nxt; int ui = 0;
    if (!S.next(0, cur)) return;
    f32x4 acc[2][2][4][2];
#pragma unroll
    for (int a = 0; a < 2; ++a)
#pragma unroll
        for (int b = 0; b < 2; ++b)
#pragma unroll
            for (int m = 0; m < 4; ++m)
#pragma unroll
                for (int n = 0; n < 2; ++n) acc[a][b][m][n] = (f32x4){0.f, 0.f, 0.f, 0.f};
    bf16x8 At[4][2], B0[2][2], B1[2][2];
    const char* cA = (const char*)g.A + (size_t)cur.pm * tstep; const char* cB = (const char*)g.Bt + (size_t)cur.pn * tstep;
    S.a_ready(cur);
    if constexpr (SP2) {
        PG8_STAGE(PG8_SB(0, 0), cB, voffB); PG8_STAGE(PG8_SB(0, 1), cB + hstep, voffB); PG8_STAGE(PG8_SA(0, 0), cA, voffA); PG8_STAGE(PG8_SA(0, 1), cA + hstep, voffA);
        if (wr == 1) PG8_BAR;
        PG8_WAIT_V(2); PG8_BAR;
        PG8_STAGE(PG8_SB(1, 0), cB + kstep, voffB); PG8_STAGE(PG8_SA(1, 0), cA + kstep, voffA); PG8_STAGE(PG8_SB(1, 1), cB + hstep + kstep, voffB);
        PG8_WAIT_V(6); PG8_BAR;
    } else {
        PG8_STAGE(PG8_SB(0, 0), cB, voffB); PG8_STAGE(PG8_SA(0, 0), cA, voffA); PG8_STAGE(PG8_SB(0, 1), cB + hstep, voffB); PG8_STAGE(PG8_SA(0, 1), cA + hstep, voffA);
        if (wr == 1) PG8_BAR;
        PG8_WAIT_V(4); PG8_BAR;
        PG8_STAGE(PG8_SB(1, 0), cB + kstep, voffB); PG8_STAGE(PG8_SA(1, 0), cA + kstep, voffA); PG8_STAGE(PG8_SB(1, 1), cB + hstep + kstep, voffB);
        PG8_WAIT_V(6); PG8_BAR;
    }
    for (;;) {
        const bool has_next = S.next(ui + 1, nxt);
        const char* nA = has_next ? (const char*)g.A + (size_t)nxt.pm * tstep : cA; const char* nB = has_next ? (const char*)g.Bt + (size_t)nxt.pn * tstep : cB;
        for (int t = 0; t < nt; t += 2) {
            const bool last = (t == nt - 2);
            const char* a1 = cA + (size_t)(t + 1) * kstep;
            const char* a2 = last ? nA : cA + (size_t)(t + 2) * kstep; const char* b2 = last ? nB : cB + (size_t)(t + 2) * kstep;
            const char* a3 = a2 + kstep; const char* b3 = b2 + kstep;
            if (last && has_next) S.a_ready(nxt);
            if constexpr (SP2) {
            PG8_LDB(B0, 0, 0); PG8_LDB(B1, 0, 1); PG8_SCHED; PG8_LDA(At, 0, 0); PG8_STAGE(PG8_SA(1, 1), a1 + hstep, voffA);
            PG8_WAIT_V(8); PG8_WAIT_L(0); PG8_BAR; PG8_MMA(0, 0, At, B0); PG8_MMA(0, 1, At, B1); PG8_BAR; PG8_SCHED;
            PG8_LDA(At, 0, 1); PG8_STAGE(PG8_SB(0, 0), b2, voffB); PG8_STAGE(PG8_SB(0, 1), b2 + hstep, voffB); PG8_STAGE(PG8_SA(0, 0), a2, voffA);
            PG8_WAIT_V(8); PG8_WAIT_L(0); PG8_BAR; PG8_MMA(1, 0, At, B0); PG8_MMA(1, 1, At, B1); PG8_BAR; PG8_SCHED;
            PG8_LDB(B0, 1, 0); PG8_LDB(B1, 1, 1); PG8_SCHED; PG8_LDA(At, 1, 0); PG8_STAGE(PG8_SA(0, 1), a2 + hstep, voffA);
            PG8_WAIT_V(8); PG8_WAIT_L(0); PG8_BAR; PG8_MMA(0, 0, At, B0); PG8_MMA(0, 1, At, B1); PG8_BAR; PG8_SCHED;
            PG8_LDA(At, 1, 1); PG8_STAGE(PG8_SB(1, 0), b3, voffB); PG8_STAGE(PG8_SB(1, 1), b3 + hstep, voffB); PG8_STAGE(PG8_SA(1, 0), a3, voffA);
            PG8_WAIT_V(8); PG8_WAIT_L(0); PG8_BAR; PG8_MMA(1, 0, At, B0); PG8_MMA(1, 1, At, B1); PG8_BAR; PG8_SCHED;
            } else {
            PG8_LDB(B0, 0, 0); PG8_SCHED; PG8_LDA(At, 0, 0); PG8_STAGE(PG8_SA(1, 1), a1 + hstep, voffA);
            PG8_WAIT_L(8); PG8_BAR; PG8_WAIT_L(0); PG8_MMA(0, 0, At, B0); PG8_BAR; PG8_SCHED;
            PG8_LDB(B1, 0, 1); PG8_STAGE(PG8_SB(0, 0), b2, voffB);
            PG8_BAR; PG8_WAIT_L(0); PG8_MMA(0, 1, At, B1); PG8_BAR;
            PG8_LDA(At, 0, 1); PG8_STAGE(PG8_SA(0, 0), a2, voffA);
            PG8_BAR; PG8_WAIT_L(0); PG8_MMA(1, 0, At, B0); PG8_BAR; PG8_SCHED;
            PG8_STAGE(PG8_SB(0, 1), b2 + hstep, voffB);
            PG8_WAIT_V(6); PG8_BAR; PG8_MMA(1, 1, At, B1); PG8_BAR;
            PG8_LDB(B0, 1, 0); PG8_SCHED; PG8_LDA(At, 1, 0); PG8_STAGE(PG8_SA(0, 1), a2 + hstep, voffA);
            PG8_WAIT_L(8); PG8_BAR; PG8_WAIT_L(0); PG8_MMA(0, 0, At, B0); PG8_BAR; PG8_SCHED;
            PG8_LDB(B1, 1, 1); PG8_STAGE(PG8_SB(1, 0), b3, voffB);
            PG8_BAR; PG8_WAIT_L(0); PG8_MMA(0, 1, At, B1); PG8_BAR;
            PG8_LDA(At, 1, 1); PG8_STAGE(PG8_SA(1, 0), a3, voffA);
            PG8_BAR; PG8_WAIT_L(0); PG8_MMA(1, 0, At, B0); PG8_BAR; PG8_SCHED;
            PG8_STAGE(PG8_SB(1, 1), b3 + hstep, voffB);
            PG8_WAIT_V(6); PG8_BAR; PG8_MMA(1, 1, At, B1); PG8_BAR;
            }
        }
        if constexpr (ALIGN_EPI) { if (wr == 0) PG8_BAR; }
        if constexpr (!Epi::AFTER_DRAIN) { E(acc, cur, wr, wc, fr, fq); S.done(cur); }
        if (!has_next) break;
#pragma unroll
        for (int a = 0; a < 2; ++a)
#pragma unroll
            for (int b = 0; b < 2; ++b)
#pragma unroll
                for (int m = 0; m < 4; ++m)
#pragma unroll
                    for (int n = 0; n < 2; ++n) acc[a][b][m][n] = (f32x4){0.f, 0.f, 0.f, 0.f};
        cur = nxt; cA = nA; cB = nB; ++ui;
        if constexpr (ALIGN_EPI) { if (wr == 1) PG8_BAR; }
    }
    PG8_WAIT_V(0);
    if constexpr (!ALIGN_EPI) { if (wr == 0) PG8_BAR; }
    PG8_BAR;
    if constexpr (Epi::AFTER_DRAIN) { E.fused(acc, cur, wr, wc, fr, fq, lds, wid, lane); S.done(cur); }
#undef PG8_SA
#undef PG8_SB
#undef PG8_STAGE
#undef PG8_LDA
#undef PG8_LDB
#undef PG8_MMA
#undef PG8_WAIT_V
#undef PG8_WAIT_L
#undef PG8_BAR
#undef PG8_SCHED
}
}
#define LAS __attribute__((address_space(3)))
using pg8::bf16_t; using pg8::bf16x8; using pg8::f32x4; using pg8::u32x4; using pg8::u32x2; using pg8::cvt_pk_bf16; using pg8::bf_lo; using pg8::bf_hi; using pg8::siluf_;
#ifndef LATE_CVT
#define LATE_CVT 1
#endif
#ifndef N_LAUNCH
#define N_LAUNCH 1
#endif
constexpr int T = 8192, D = 2048, FF = 5504, NGU = 11008, NP = pg8::NP, NINP = 11520, H = 8, NCH = 128;
constexpr int P_GQ = 0, P_GK = 1024, P_GV = 2048, P_GZ = 3072, P_AQ = 4096, P_AK = 5120, P_AV = 6144, P_G1 = 7168, P_G2 = 9216;
constexpr float EPS = 1e-6f, L2E = 1.4426950408889634f;
constexpr size_t MiB = 1u << 20;
constexpr size_t WS_CTL = 0;
constexpr size_t WS_WIN = 1 * MiB, WS_WA = 46 * MiB, WS_WB = 50 * MiB, WS_WOUT = 54 * MiB, WS_WGU2 = 62 * MiB, WS_WD2 = 105 * MiB;
constexpr size_t WS_XB = 127 * MiB, WS_OG = 127 * MiB, WS_OA = 143 * MiB;
constexpr size_t WS_P = 159 * MiB;
constexpr size_t WS_WGU1 = 159 * MiB, WS_WD1 = 202 * MiB, WS_ACT1 = 224 * MiB, WS_ACT2 = 159 * MiB;
constexpr size_t WS_WN = 336 * MiB, WS_QG = 352 * MiB, WS_KDT = 368 * MiB, WS_U = 384 * MiB, WS_AQK = 416 * MiB, WS_M = 336 * MiB, WS_ORAW = 424 * MiB, WS_END = 440 * MiB;
constexpr int CW_SS1 = 0, CW_SS2 = 8192, CW_SS3 = 16384, CW_CD = 24576, CW_SHIFT = 25600, CW_AB = 32768;
constexpr int LDS_BYTES = 147456;
constexpr size_t WS_BAR = 768 * 1024;

#define LDS_WAIT() asm volatile("s_waitcnt lgkmcnt(0)" ::: "memory")
#define BAR_LDS() asm volatile("s_waitcnt lgkmcnt(0)\n\ts_barrier" ::: "memory")
__device__ __forceinline__ float wave_sum(float v) {
#pragma unroll
    for (int o = 1; o < 64; o <<= 1) v += __shfl_xor(v, o);
    return v;
}
__device__ __forceinline__ bf16_t f2bf1(float x) { return (bf16_t)(cvt_pk_bf16(x, 0.f) & 0xffffu); }
__device__ __forceinline__ void unpack16(const u32x4 a, const u32x4 b, float (&o)[16]) {
    o[0] = bf_lo(a.x); o[1] = bf_hi(a.x); o[2] = bf_lo(a.y); o[3] = bf_hi(a.y); o[4] = bf_lo(a.z); o[5] = bf_hi(a.z); o[6] = bf_lo(a.w); o[7] = bf_hi(a.w);
    o[8] = bf_lo(b.x); o[9] = bf_hi(b.x); o[10] = bf_lo(b.y); o[11] = bf_hi(b.y); o[12] = bf_lo(b.z); o[13] = bf_hi(b.z); o[14] = bf_lo(b.w); o[15] = bf_hi(b.w);
}
__device__ __forceinline__ void ld16bf(const bf16_t* p, float (&o)[16]) { unpack16(*(const u32x4*)p, *(const u32x4*)(p + 8), o); }
__device__ __forceinline__ void ld16f(const float* p, float (&o)[16]) {
#pragma unroll
    for (int e = 0; e < 4; ++e) { const f32x4 w = *(const f32x4*)(p + 4 * e); o[4 * e] = w[0]; o[4 * e + 1] = w[1]; o[4 * e + 2] = w[2]; o[4 * e + 3] = w[3]; }
}
__device__ __forceinline__ void pack16(const float (&v)[16], u32x4& a, u32x4& b) {
    a.x = cvt_pk_bf16(v[0], v[1]); a.y = cvt_pk_bf16(v[2], v[3]); a.z = cvt_pk_bf16(v[4], v[5]); a.w = cvt_pk_bf16(v[6], v[7]);
    b.x = cvt_pk_bf16(v[8], v[9]); b.y = cvt_pk_bf16(v[10], v[11]); b.z = cvt_pk_bf16(v[12], v[13]); b.w = cvt_pk_bf16(v[14], v[15]);
}
__device__ __forceinline__ void st16bf_g(bf16_t* p, const float (&v)[16]) { u32x4 a, b; pack16(v, a, b); *(u32x4*)p = a; *(u32x4*)(p + 8) = b; }
__device__ __forceinline__ void st16bf_l(LAS bf16_t* p, const float (&v)[16]) { u32x4 a, b; pack16(v, a, b); *(LAS u32x4*)p = a; *(LAS u32x4*)(p + 8) = b; }
__device__ __forceinline__ bf16x8 mk8(unsigned a, unsigned b, unsigned c, unsigned d) { const u32x4 w = {a, b, c, d}; return __builtin_bit_cast(bf16x8, w); }
#define MFMA16(a, b, c) __builtin_amdgcn_mfma_f32_16x16x32_bf16((a), (b), (c), 0, 0, 0)
typedef short bf16x4 __attribute__((ext_vector_type(4)));
#define MFMA16K16(a, b, c) __builtin_amdgcn_mfma_f32_16x16x16bf16_1k((a), (b), (c), 0, 0, 0)
__device__ __forceinline__ bf16x4 mk4(float a, float b, float c, float d) { const u32x2 w = {cvt_pk_bf16(a, b), cvt_pk_bf16(c, d)}; return __builtin_bit_cast(bf16x4, w); }

struct CvtDesc { const float* W; bf16_t* WT; const float* ks; int ldN, srcn0, nvalid, K, k0, dstrow0; };
template <bool NT> __device__ __forceinline__ void cvt_load(const CvtDesc& d, int lane, f32x4 (&v)[16]) {
    const int kr = lane >> 4, nc = (lane & 15) * 4;
#pragma unroll
    for (int i = 0; i < 16; ++i) { const int k = i * 4 + kr; const f32x4* src = (const f32x4*)(d.W + (size_t)(d.k0 + k) * d.ldN + d.srcn0 + nc);
        v[i] = (nc < d.nvalid) ? (NT ? __builtin_nontemporal_load(src) : *src) : (f32x4){0.f, 0.f, 0.f, 0.f}; }
}
template <bool NT> __device__ __forceinline__ void cvt_store(const CvtDesc& d, const f32x4 (&v)[16], LAS float* scr, int lane) {
    const int kr = lane >> 4, nc = (lane & 15) * 4;
#pragma unroll
    for (int i = 0; i < 16; ++i) { const int k = i * 4 + kr; const float s = d.ks ? d.ks[d.k0 + k] : 1.f; LAS float* p = scr + k * 65 + nc;
        p[0] = v[i][0] * s; p[1] = v[i][1] * s; p[2] = v[i][2] * s; p[3] = v[i][3] * s; }
    LDS_WAIT();
    const int c = lane & 7, nrow = lane >> 3;
#pragma unroll
    for (int j = 0; j < 8; ++j) { const int n = j * 8 + nrow; const LAS float* s = scr + (8 * c) * 65 + n;
        u32x4 o; o.x = cvt_pk_bf16(s[0], s[65]); o.y = cvt_pk_bf16(s[130], s[195]); o.z = cvt_pk_bf16(s[260], s[325]); o.w = cvt_pk_bf16(s[390], s[455]);
        u32x4* dst = (u32x4*)(d.WT + (size_t)(d.dstrow0 + n) * d.K + d.k0 + 8 * c);
        if (NT) __builtin_nontemporal_store(o, dst); else *dst = o; }
    LDS_WAIT();
}
struct Ptrs {
    const float* in[21]; float* out; unsigned char* ws;
};
constexpr int I_GU = 32 * 172, I_DN = 86 * 32, I_IN = 32 * 180, I_AB = 16 * 32, I_OUT = 32 * 32;
constexpr int NITEMS = 2 * (I_GU + I_DN) + I_IN + 2 * I_AB + I_OUT, N_EARLY = I_GU + I_DN + I_IN, N_LATE1 = 6200;
constexpr int R_GU1 = 0, R_DN1 = I_GU, R_IN = R_DN1 + I_DN, R_GU2 = R_IN + I_IN, R_DN2 = R_GU2 + I_GU, R_A = R_DN2 + I_DN, R_END = NITEMS;
constexpr int GU2_SPLIT = R_GU2 + 3448;
__device__ __forceinline__ CvtDesc cvt_gu_desc(int r, const float* Wg, const float* Wu, const float* nrm, bf16_t* WT) {
    const int kb = r % 32, nb = r / 32, pn = nb >> 2, half = (nb & 3) >> 1, j0 = (nb & 1) * 64;
    return CvtDesc{half ? Wu : Wg, WT, nrm, FF, pn * 128 + j0, 64, D, kb * 64, nb * 64};
}
__device__ __forceinline__ CvtDesc cvt_decode(const Ptrs& A, int it) {
    unsigned char* ws = A.ws; int r = it;
    if (r < I_GU) return cvt_gu_desc(r, A.in[2], A.in[3], A.in[1], (bf16_t*)(ws + WS_WGU1)); r -= I_GU;
    if (r < I_DN) return CvtDesc{A.in[4], (bf16_t*)(ws + WS_WD1), nullptr, D, (r / 86) * 64, 64, FF, (r % 86) * 64, (r / 86) * 64}; r -= I_DN;
    if (r < I_IN) { const int kb = r % 32, nb = r / 32, c0 = nb * 64; int src, nv;
        if (c0 < 4096) { src = c0; nv = 64; } else if (c0 < 11264) { src = c0 + 16; nv = 64; } else if (c0 == 11264) { src = 4096; nv = 16; } else { src = 0; nv = 0; }
        return CvtDesc{A.in[6], (bf16_t*)(ws + WS_WIN), A.in[5], 11280, src, nv, D, kb * 64, c0}; } r -= I_IN;
    if (r < I_GU) return cvt_gu_desc(r, A.in[18], A.in[19], A.in[17], (bf16_t*)(ws + WS_WGU2)); r -= I_GU;
    if (r < I_DN) return CvtDesc{A.in[20], (bf16_t*)(ws + WS_WD2), nullptr, D, (r / 86) * 64, 64, FF, (r % 86) * 64, (r / 86) * 64}; r -= I_DN;
    if (r < I_AB) return CvtDesc{A.in[14], (bf16_t*)(ws + WS_WA), nullptr, D, (r / 16) * 64, 64, 1024, (r % 16) * 64, (r / 16) * 64}; r -= I_AB;
    if (r < I_AB) return CvtDesc{A.in[15], (bf16_t*)(ws + WS_WB), nullptr, D, (r / 16) * 64, 64, 1024, (r % 16) * 64, (r / 16) * 64}; r -= I_AB;
    return CvtDesc{A.in[16], (bf16_t*)(ws + WS_WOUT), nullptr, D, (r / 32) * 64, 64, D, (r % 32) * 64, (r / 32) * 64};
}
template <bool NT = false> __device__ __forceinline__ void cvt_items(const Ptrs& A, LAS unsigned char* lds, int gw, int NGW, int it_lo, int it_hi, int lo2 = 0, int hi2 = 0) {
    const int tid = threadIdx.x, lane = tid & 63, wave = tid >> 6;
    LAS float* scr = (LAS float*)(lds + wave * 16640);
    const int n1 = it_hi - it_lo, ntot = n1 + (hi2 - lo2);
#define CVT_MAP(v) ((v) < n1 ? it_lo + (v) : lo2 + ((v) - n1))
    int it = gw; if (it >= ntot) return;
    CvtDesc d = cvt_decode(A, CVT_MAP(it)); f32x4 v[16]; cvt_load<NT>(d, lane, v);
    for (;;) {
        const int itn = it + NGW; const bool has = itn < ntot;
        CvtDesc dn = d; f32x4 w[16];
        if (has) { dn = cvt_decode(A, CVT_MAP(itn)); cvt_load<NT>(dn, lane, w); }
        cvt_store<NT>(d, v, scr, lane);
        if (!has) break;
        d = dn; it = itn;
#pragma unroll
        for (int i = 0; i < 16; ++i) v[i] = w[i];
    }
#undef CVT_MAP
}
__device__ __forceinline__ void p0_prologue(const Ptrs& A, LAS unsigned char* lds, int vcu, int G) {
    const int tid = threadIdx.x, lane = tid & 63, wave = tid >> 6;
    unsigned char* ws = A.ws; float* ctl = (float*)(ws + WS_CTL);
    const int gw = vcu * 8 + wave, NGW = G * 8;
    if (LATE_CVT && G == 256) cvt_items(A, lds, gw, NGW, R_GU1, R_DN1, R_IN, R_GU2);
    else cvt_items(A, lds, gw, NGW, 0, NITEMS);
    const float* x = A.in[0]; bf16_t* XB = (bf16_t*)(ws + WS_XB);
    for (int m = gw; m < T; m += NGW) {
        const f32x4* xr = (const f32x4*)(x + (size_t)m * D) + lane; f32x4 v[8]; float s = 0.f;
#pragma unroll
        for (int j = 0; j < 8; ++j) { v[j] = xr[64 * j]; s += (v[j][0] * v[j][0] + v[j][1] * v[j][1]) + (v[j][2] * v[j][2] + v[j][3] * v[j][3]); }
        s = wave_sum(s);
        u32x2* o8 = (u32x2*)(XB + (size_t)m * D) + lane;
#pragma unroll
        for (int j = 0; j < 8; ++j) { u32x2 w; w.x = cvt_pk_bf16(v[j][0], v[j][1]); w.y = cvt_pk_bf16(v[j][2], v[j][3]); o8[64 * j] = w; }
        if (lane == 0) ctl[CW_SS1 + m] = s;
    }
    for (int i = vcu * 512 + tid; i < 16384; i += G * 512) ctl[CW_SS2 + i] = 0.f;
    if (vcu == 0 && wave == 0) {
        const float* qw = A.in[11]; const float* kw = A.in[12];
        float mq = fmaxf(fabsf(qw[lane]), fabsf(qw[lane + 64])), mk = fmaxf(fabsf(kw[lane]), fabsf(kw[lane + 64]));
#pragma unroll
        for (int o = 1; o < 64; o <<= 1) { mq = fmaxf(mq, __shfl_xor(mq, o)); mk = fmaxf(mk, __shfl_xor(mk, o)); }
        if (lane == 0) ctl[CW_SHIFT] = 11.313708498984761f * mq * mk * L2E;
    }
}
#define RLX_AGENT __ATOMIC_RELAXED, __HIP_MEMORY_SCOPE_AGENT
#define XB_TMO      128
#define XB_XCNT(j)  (256  + 64 * (j))
#define XB_XSUB(j)  (1280 + 64 * (j))
#define XB_XGEN(j)  (2304 + 64 * (j))
#define XB_TOP      3328
#define XB_TOPGEN   3392
#define XCD_BAR_WORDS 3456
#define XB_SPIN_CAP (1u << 18)

__device__ __forceinline__ unsigned xb_ld(unsigned* p)              { return __hip_atomic_load(p, __ATOMIC_RELAXED, __HIP_MEMORY_SCOPE_AGENT); }
__device__ __forceinline__ unsigned xb_add(unsigned* p, unsigned v) { return __hip_atomic_fetch_add(p, v, __ATOMIC_RELAXED, __HIP_MEMORY_SCOPE_AGENT); }
__device__ __forceinline__ unsigned xb_xcc_id() { return (unsigned)__builtin_amdgcn_s_getreg((3 << 11) | 20) & 0xFu; }
#define XB_SPIN(cond, bar) do { unsigned _sp = 0; while (cond) { __builtin_amdgcn_s_sleep(1); \
    if ((++_sp & 255u) == 0u) { if (xb_ld(&(bar)[XB_TMO])) break; if (_sp > XB_SPIN_CAP) { atomicAdd(&(bar)[XB_TMO], 1u); break; } } } } while (0)

struct XcdBarrier {
    unsigned* bar; unsigned x;
    volatile LAS unsigned* st;
};

__device__ __forceinline__ XcdBarrier xcd_barrier_post(unsigned* bar, volatile LAS unsigned* st) {
    XcdBarrier b; b.bar = bar; b.x = xb_xcc_id(); b.st = st;
    if (threadIdx.x == 0) (void)xb_add(&bar[XB_XCNT(b.x)], 1u);
    return b;
}
__device__ __forceinline__ void xcd_barrier_complete(unsigned* bar, unsigned x, unsigned& nloc, unsigned& nx) {
    const unsigned G = gridDim.x * gridDim.y * gridDim.z;
    unsigned sum, cnt, mine, sp = 0u;
    for (;;) {
        sum = 0u; cnt = 0u; mine = 0u;
#pragma unroll
        for (unsigned j = 0; j < 16; ++j) { const unsigned c = xb_ld(&bar[XB_XCNT(j)]); sum += c; cnt += (c > 0u) ? 1u : 0u; mine = (j == x) ? c : mine; }
        if (sum == G) break;
        __builtin_amdgcn_s_sleep(1);
        if ((++sp & 255u) == 0u) { if (xb_ld(&bar[XB_TMO])) break; if (sp > XB_SPIN_CAP) { atomicAdd(&bar[XB_TMO], 1u); break; } }
    }
    nloc = mine > 0u ? mine : 1u; nx = cnt > 0u ? cnt : 1u;
}

__device__ __forceinline__ void xcd_barrier(const XcdBarrier& b) {
    asm volatile("s_waitcnt vmcnt(0)" ::: "memory");
    __syncthreads();
    if (threadIdx.x == 0) {
        unsigned* bar = b.bar;
        __builtin_amdgcn_s_waitcnt(0);
        unsigned nloc = b.st[0], nx = b.st[1];
        if (nloc == 0u) { xcd_barrier_complete(bar, b.x, nloc, nx); b.st[0] = nloc; b.st[1] = nx; }
        const unsigned old = xb_add(&bar[XB_XSUB(b.x)], 1u);
        const unsigned gen = old / nloc;
        if (old + 1u == (gen + 1u) * nloc) {
            __builtin_amdgcn_fence(__ATOMIC_RELEASE, "agent");
            asm volatile("s_waitcnt vmcnt(0)" ::: "memory");
            const unsigned og = xb_add(&bar[XB_TOP], 1u);
            const unsigned tg = og / nx;
            if (og + 1u == (tg + 1u) * nx) xb_add(&bar[XB_TOPGEN], 1u);
            else XB_SPIN(xb_ld(&bar[XB_TOPGEN]) == tg, bar);
            __builtin_amdgcn_fence(__ATOMIC_ACQUIRE, "agent");
            xb_add(&bar[XB_XGEN(b.x)], 1u);
            asm volatile("s_waitcnt vmcnt(0)" ::: "memory");
        } else {
            XB_SPIN(xb_ld(&bar[XB_XGEN(b.x)]) == gen, bar);
            __builtin_amdgcn_fence(__ATOMIC_ACQUIRE, "agent");
            asm volatile("s_waitcnt vmcnt(0)" ::: "memory");
        }
    }
    __syncthreads();
}
template <int MODE = 7> __device__ __forceinline__ void gdn_prep_unit(LAS unsigned char* lds, int c, int h, bf16_t* P, const float* AB, const float* convw, const float* A_log, const float* dt_bias, const float* kw,
                                              bf16_t* WN, bf16_t* QG, bf16_t* KDT, float* U, bf16_t* AQK, float* CD) {
    const int tid = threadIdx.x, lane = tid & 63, wave = __builtin_amdgcn_readfirstlane(tid >> 6);
    LAS bf16_t* KT = (LAS bf16_t*)(lds); LAS bf16_t* KBT = (LAS bf16_t*)(lds + 17408); LAS bf16_t* QT = (LAS bf16_t*)(lds + 34816);
    LAS float* X = (LAS float*)(lds + 52224); LAS float* AS = (LAS float*)(lds + 117760);
    LAS float* GS = (LAS float*)(lds + 134144); LAS float* BS = GS + 64; LAS float* GC = GS + 128; LAS float* ED = GS + 192;
    const int i = tid >> 3, sub = tid & 7, d0 = sub * 16, t = c * 64 + i;
    float ab_a = 0.f, ab_b = 0.f;
    if (sub == 0) { ab_a = AB[(size_t)t * 16 + h]; ab_b = AB[(size_t)t * 16 + 8 + h]; }
    u32x4 av0 = {0u, 0u, 0u, 0u}, av1 = {0u, 0u, 0u, 0u};
    if (MODE & 1) {   bf16_t* kp = P + (size_t)t * NP + P_AK + h * 128 + d0; const bf16_t* vp = P + (size_t)t * NP + P_AV + h * 128 + d0;
        float kv[16], kwv[16]; ld16bf(kp, kv); av0 = *(const u32x4*)vp; av1 = *(const u32x4*)(vp + 8); ld16f(kw + d0, kwv);
        float ss = 0.f;
#pragma unroll
        for (int e = 0; e < 16; ++e) ss += kv[e] * kv[e];
        ss += __shfl_xor(ss, 1); ss += __shfl_xor(ss, 2); ss += __shfl_xor(ss, 4);
        const float rs = rsqrtf(ss * (1.0f / 128.0f) + EPS);
#pragma unroll
        for (int e = 0; e < 16; ++e) kv[e] *= rs * kwv[e];
        st16bf_g(kp, kv);
        *(LAS u32x4*)(KT + i * 136 + d0) = av0; *(LAS u32x4*)(KT + i * 136 + d0 + 8) = av1;
    }
    float q[16], k[16], v[16];
#pragma unroll
    for (int sec = 0; sec < 3; ++sec) {
        float acc[16];
#pragma unroll
        for (int e = 0; e < 16; ++e) acc[e] = 0.f;
        const int col = sec * 1024 + h * 128 + d0;
#pragma unroll
        for (int kk = 0; kk < 4; ++kk) {
            const int tt = t - 3 + kk;
            if (tt >= 0) { float xv[16], wv[16]; ld16bf(P + (size_t)tt * NP + col, xv); ld16f(convw + kk * 3072 + col, wv);
#pragma unroll
                for (int e = 0; e < 16; ++e) acc[e] += wv[e] * xv[e]; }
        }
#pragma unroll
        for (int e = 0; e < 16; ++e) { const float r = siluf_(acc[e]); if (sec == 0) q[e] = r; else if (sec == 1) k[e] = r; else v[e] = r; }
    }
    float sq = 0.f, sk = 0.f;
#pragma unroll
    for (int e = 0; e < 16; ++e) { sq += q[e] * q[e]; sk += k[e] * k[e]; }
    sq += __shfl_xor(sq, 1); sq += __shfl_xor(sq, 2); sq += __shfl_xor(sq, 4);
    sk += __shfl_xor(sk, 1); sk += __shfl_xor(sk, 2); sk += __shfl_xor(sk, 4);
    const float rq = rsqrtf(sq + EPS) * 0.08838834764831845f, rk = rsqrtf(sk + EPS);
#pragma unroll
    for (int e = 0; e < 16; ++e) { q[e] *= rq; k[e] *= rk; }
    if (sub == 0) { const float a = ab_a, b = ab_b; const float xx = a + dt_bias[h];
        const float sp = fmaxf(xx, 0.f) + log1pf(expf(-fabsf(xx)));
        GS[i] = -expf(A_log[h]) * sp; BS[i] = 1.0f / (1.0f + expf(-b)); }
    BAR_LDS();
    if (MODE & 1) {
#pragma unroll
        for (int q2 = 0; q2 < 2; ++q2) { const int ch = tid + 512 * q2, d = ch & 127, k8 = ch >> 7; const LAS bf16_t* vp = KT + (8 * k8) * 136 + d;
            u32x4 w; w.x = (unsigned)vp[0] | ((unsigned)vp[136] << 16); w.y = (unsigned)vp[2 * 136] | ((unsigned)vp[3 * 136] << 16);
            w.z = (unsigned)vp[4 * 136] | ((unsigned)vp[5 * 136] << 16); w.w = (unsigned)vp[6 * 136] | ((unsigned)vp[7 * 136] << 16);
            *(u32x4*)(P + (size_t)(c * 64 + (d >> 1)) * NP + P_AV + h * 128 + (d & 1) * 64 + 8 * k8) = w; }
    }
    if (wave == 0) { float g = GS[lane];
#pragma unroll
        for (int o = 1; o < 64; o <<= 1) { const float y = __shfl_up(g, o); if (lane >= o) g += y; }
        GC[lane] = g; ED[lane] = __expf(__shfl(g, 63) - g); }
    BAR_LDS();
    const float beta = BS[i], Gi = GC[i], Gl = GC[63];
    const float eg = __expf(Gi);
    float tmp[16];
    if (!(MODE & 8)) {
    st16bf_l(KT + i * 136 + d0, k);
#pragma unroll
    for (int e = 0; e < 16; ++e) tmp[e] = k[e] * beta;
    st16bf_l(KBT + i * 136 + d0, tmp);
    st16bf_l(QT + i * 136 + d0, q);
#pragma unroll
    for (int e = 0; e < 4; ++e) {
        *(LAS f32x4*)(X + i * 256 + d0 + 4 * e) = (f32x4){v[4 * e] * beta, v[4 * e + 1] * beta, v[4 * e + 2] * beta, v[4 * e + 3] * beta};
        *(LAS f32x4*)(X + i * 256 + 128 + d0 + 4 * e) = (f32x4){tmp[4 * e] * eg, tmp[4 * e + 1] * eg, tmp[4 * e + 2] * eg, tmp[4 * e + 3] * eg}; }
    }
    if (!(MODE & 16)) {
#pragma unroll
    for (int e = 0; e < 16; ++e) tmp[e] = q[e] * eg;
    const size_t pk_off = ((size_t)h * NCH + c) * 8192 + (size_t)((i >> 4) * 4 + (sub >> 1)) * 512 + (size_t)((((2 * sub) & 3) * 16 + (i & 15)) * 8);
    { u32x4 a, b; pack16(tmp, a, b); *(u32x4*)(QG + pk_off) = a; *(u32x4*)(QG + pk_off + 128) = b; }
    }
    BAR_LDS();
    if (!(MODE & 16)) {
        bf16_t* kdb = KDT + ((size_t)h * NCH + c) * 8192;
#pragma unroll
        for (int q2 = 0; q2 < 2; ++q2) { const int ch = tid + 512 * q2, d = ch & 127, i8 = ch >> 7; const LAS bf16_t* kp = KT + (8 * i8) * 136 + d; const LAS float* ep = ED + 8 * i8;
            float kv[8];
#pragma unroll
            for (int r = 0; r < 8; ++r) kv[r] = __uint_as_float((unsigned)kp[r * 136] << 16) * ep[r];
            u32x4 w; w.x = cvt_pk_bf16(kv[0], kv[1]); w.y = cvt_pk_bf16(kv[2], kv[3]); w.z = cvt_pk_bf16(kv[4], kv[5]); w.w = cvt_pk_bf16(kv[6], kv[7]);
            *(u32x4*)(kdb + (size_t)((d >> 4) * 2 + (i8 >> 2)) * 512 + (size_t)((i8 & 3) * 16 + (d & 15)) * 8) = w; }
    }
    if (MODE & 2) {
        const int fr = lane & 15, fq = lane >> 4, mt = wave >> 2, it = wave & 3;
        const LAS bf16_t* Asrc = mt ? QT : KBT;
        bf16x8 af[4];
#pragma unroll
        for (int kk = 0; kk < 4; ++kk) af[kk] = *(const LAS bf16x8*)(Asrc + (16 * it + fr) * 136 + 32 * kk + 8 * fq);
        bf16_t* aqk = AQK + ((size_t)h * NCH + c) * 4096;
        for (int jt = 0; jt < 4; ++jt) {
            f32x4 acc = {0.f, 0.f, 0.f, 0.f};
            if (jt <= it) {
#pragma unroll
                for (int kk = 0; kk < 4; ++kk) { const bf16x8 b = *(const LAS bf16x8*)(KT + (16 * jt + fr) * 136 + 32 * kk + 8 * fq); acc = MFMA16(af[kk], b, acc); }
            }
            const int j = 16 * jt + fr; const float Gj = GC[j];
#pragma unroll
            for (int r = 0; r < 4; ++r) { const int ii = 16 * it + 4 * fq + r; const float Gii = GC[ii];
                const bool keep = mt ? (ii >= j) : (ii > j);
                const float val = keep ? acc[r] * __expf(fminf(Gii - Gj, 0.f)) : 0.f;
                if (mt == 0) AS[ii * 64 + j] = val; else aqk[((ii >> 4) * 2 + (j >> 5)) * 512 + (((j >> 3) & 3) * 16 + (ii & 15)) * 8 + (j & 7)] = f2bf1(val); }
        }
    }
    BAR_LDS();
    LAS float* TB = (LAS float*)(lds + 135168);
    if ((MODE & 4) && wave == 0) {
        const int bb = lane >> 4, jc = lane & 15; const LAS float* Ab = AS + (16 * bb) * 64 + 16 * bb;
        float tc[16];
#pragma unroll
        for (int r = 0; r < 16; ++r) { float a0 = (r == jc) ? 1.f : 0.f;
#pragma unroll
            for (int m = 0; m < r; ++m) a0 -= Ab[r * 64 + m] * tc[m];
            tc[r] = a0; }
#pragma unroll
        for (int r = 0; r < 16; ++r) TB[bb * 256 + r * 16 + jc] = tc[r];
    }
    BAR_LDS();
    if (MODE & 4) {   const int fr = lane & 15, fq = lane >> 4;
        f32x4 acc[4][2];
#pragma unroll
        for (int rb = 0; rb < 4; ++rb)
#pragma unroll
            for (int q2 = 0; q2 < 2; ++q2) { const LAS float* xp = X + (16 * rb + 4 * fq) * 256 + 32 * wave + 16 * q2 + fr; acc[rb][q2] = (f32x4){xp[0], xp[256], xp[512], xp[768]}; }
#pragma unroll
        for (int bb = 0; bb < 4; ++bb) {
            const f32x4 tf = *(const LAS f32x4*)(TB + bb * 256 + fr * 16 + 4 * fq); const bf16x4 ta = mk4(tf[0], tf[1], tf[2], tf[3]);
            bf16x4 xb[2];
#pragma unroll
            for (int q2 = 0; q2 < 2; ++q2) { const bf16x4 rbf = mk4(acc[bb][q2][0], acc[bb][q2][1], acc[bb][q2][2], acc[bb][q2][3]);
                acc[bb][q2] = MFMA16K16(ta, rbf, ((f32x4){0.f, 0.f, 0.f, 0.f}));
                xb[q2] = mk4(acc[bb][q2][0], acc[bb][q2][1], acc[bb][q2][2], acc[bb][q2][3]); }
#pragma unroll
            for (int ib = bb + 1; ib < 4; ++ib) { const f32x4 af = *(const LAS f32x4*)(AS + (16 * ib + fr) * 64 + 16 * bb + 4 * fq); const bf16x4 na = mk4(-af[0], -af[1], -af[2], -af[3]);
#pragma unroll
                for (int q2 = 0; q2 < 2; ++q2) acc[ib][q2] = MFMA16K16(na, xb[q2], acc[ib][q2]); }
        }
        if (wave < 4) {
            float* up = U + ((size_t)h * NCH + c) * 8192;
#pragma unroll
            for (int rb = 0; rb < 4; ++rb)
#pragma unroll
                for (int q2 = 0; q2 < 2; ++q2) *(f32x4*)(up + (size_t)(((2 * wave + q2) * 4 + rb) * 64 + lane) * 4) = acc[rb][q2];
        } else {
            bf16_t* wp = WN + ((size_t)h * NCH + c) * 8192 + (size_t)(wave - 4) * 512 + (size_t)((fr >> 3) * 16 + 4 * fq) * 8 + (fr & 7);
#pragma unroll
            for (int rb = 0; rb < 4; ++rb)
#pragma unroll
                for (int q2 = 0; q2 < 2; ++q2)
#pragma unroll
                    for (int r = 0; r < 4; ++r) wp[(size_t)rb * 2048 + (size_t)(2 * q2 * 16 + r) * 8] = f2bf1(-acc[rb][q2][r]);
        }
        if (tid == 0) CD[h * NCH + c] = expf(Gl);
    }
    BAR_LDS();
}

__device__ __forceinline__ void gdn_scan(LAS unsigned char* lds, int h, int s, const bf16_t* WN, const bf16_t* QG, const bf16_t* KDT, const float* U, const bf16_t* AQK, const float* CD,
                                         bf16_t* Oraw, int opitch) {
    const int tid = threadIdx.x, lane = tid & 63, wave = __builtin_amdgcn_readfirstlane(tid >> 6), fr = lane & 15, fq = lane >> 4, e0 = 16 * s;
    LAS bf16_t* ST = (LAS bf16_t*)lds;
    LAS bf16_t* VT = (LAS bf16_t*)(lds + 4352);
    for (int idx = tid; idx < 16 * 136 / 2; idx += 512) ((LAS unsigned*)ST)[idx] = 0u;
    BAR_LDS();
    const bool lo = wave < 4; const int it = wave & 3;
    const bf16_t* a1p = (lo ? WN : QG) + (size_t)h * NCH * 8192 + (size_t)(it * 4) * 512 + lane * 8;
    const bf16_t* aqp = AQK + (size_t)h * NCH * 4096 + (size_t)(it * 2) * 512 + lane * 8;
    const bf16_t* kdp = KDT + (size_t)h * NCH * 8192 + (size_t)(wave * 2) * 512 + lane * 8;
    const float* up = U + (size_t)h * NCH * 8192 + (size_t)((s * 4 + it) * 64 + lane) * 4;
    bf16_t* op = Oraw + (size_t)(16 * it + 4 * fq) * opitch + h * 128 + e0 + fr;
    f32x4 S = {0.f, 0.f, 0.f, 0.f};
    constexpr int PD = 4;
    bf16x8 rA1[PD][4], rAq[PD][2], rKd[PD][2]; f32x4 rU[PD]; float rcd[PD];
#define SCAN_LOAD(st, cc) do { const size_t c_ = (size_t)(cc); \
        _Pragma("unroll") for (int kk = 0; kk < 4; ++kk) rA1[st][kk] = *(const bf16x8*)(a1p + c_ * 8192 + 512 * kk); \
        _Pragma("unroll") for (int kk = 0; kk < 2; ++kk) rKd[st][kk] = *(const bf16x8*)(kdp + c_ * 8192 + 512 * kk); \
        if (lo) rU[st] = *(const f32x4*)(up + c_ * 8192); \
        else { _Pragma("unroll") for (int kk = 0; kk < 2; ++kk) rAq[st][kk] = *(const bf16x8*)(aqp + c_ * 4096 + 512 * kk); } \
        rcd[st] = CD[h * NCH + (cc)]; } while (0)
#pragma unroll
    for (int st = 0; st < PD; ++st) { rU[st] = (f32x4){0.f, 0.f, 0.f, 0.f}; rAq[st][0] = rAq[st][1] = (bf16x8){0, 0, 0, 0, 0, 0, 0, 0}; SCAN_LOAD(st, st); }
#pragma unroll 8
    for (int c0 = 0; c0 < NCH; c0 += PD) {
#pragma unroll
        for (int st = 0; st < PD; ++st) {
            const int c = c0 + st;
            f32x4 acc = rU[st];
#pragma unroll
            for (int kk = 0; kk < 4; ++kk) { const bf16x8 sb = *(const LAS bf16x8*)(ST + fr * 136 + 32 * kk + 8 * fq); acc = MFMA16(rA1[st][kk], sb, acc); }
            if (lo) { u32x2 w; w.x = cvt_pk_bf16(acc[0], acc[1]); w.y = cvt_pk_bf16(acc[2], acc[3]); *(LAS u32x2*)(VT + fr * 72 + 16 * it + 4 * fq) = w; }
            BAR_LDS();
            bf16x8 vb[2];
#pragma unroll
            for (int kk = 0; kk < 2; ++kk) vb[kk] = *(const LAS bf16x8*)(VT + fr * 72 + 32 * kk + 8 * fq);
            if (!lo) {
#pragma unroll
                for (int kk = 0; kk < 2; ++kk) acc = MFMA16(rAq[st][kk], vb[kk], acc);
#pragma unroll
                for (int r = 0; r < 4; ++r) op[((size_t)c * 64 + r) * opitch] = f2bf1(acc[r]);
            }
            S = S * rcd[st];
#pragma unroll
            for (int kk = 0; kk < 2; ++kk) S = MFMA16(rKd[st][kk], vb[kk], S);
            { u32x2 w; w.x = cvt_pk_bf16(S[0], S[1]); w.y = cvt_pk_bf16(S[2], S[3]); *(LAS u32x2*)(ST + fr * 136 + 16 * wave + 4 * fq) = w; }
            if (c + PD < NCH) SCAN_LOAD(st, c + PD);
            BAR_LDS();
        }
    }
#undef SCAN_LOAD
}

__device__ __forceinline__ void attn_unit(LAS unsigned char* lds, int n, int h, const bf16_t* P, const float* qw, const float* relb, float shift, bf16_t* OA) {
    const int tid = threadIdx.x, lane = tid & 63, wave = __builtin_amdgcn_readfirstlane(tid >> 6), fr = lane & 15, fq = lane >> 4, it = wave >> 1, kh = wave & 1;
    LAS bf16_t* KS = (LAS bf16_t*)lds; LAS bf16_t* VTS = (LAS bf16_t*)(lds + 17408); LAS float* BIAS = (LAS float*)(lds + 34816);
    for (int idx = tid; idx < 320; idx += 512) BIAS[idx] = relb[h * 320 + idx] * L2E;
    bf16x8 qf[4];
    {   const bf16_t* qp = P + (size_t)(n * 64 + 16 * it + fr) * NP + P_AQ + h * 128 + 8 * fq;
        float qv[4][8]; float ss = 0.f;
#pragma unroll
        for (int kk = 0; kk < 4; ++kk) { const u32x4 a = *(const u32x4*)(qp + 32 * kk);
            qv[kk][0] = bf_lo(a.x); qv[kk][1] = bf_hi(a.x); qv[kk][2] = bf_lo(a.y); qv[kk][3] = bf_hi(a.y); qv[kk][4] = bf_lo(a.z); qv[kk][5] = bf_hi(a.z); qv[kk][6] = bf_lo(a.w); qv[kk][7] = bf_hi(a.w);
#pragma unroll
            for (int e = 0; e < 8; ++e) ss += qv[kk][e] * qv[kk][e]; }
        ss += __shfl_xor(ss, 16); ss += __shfl_xor(ss, 32);
        const float rs = rsqrtf(ss * (1.0f / 128.0f) + EPS) * (0.08838834764831845f * L2E);
#pragma unroll
        for (int kk = 0; kk < 4; ++kk) { const float* wp = qw + 32 * kk + 8 * fq; const f32x4 w0 = *(const f32x4*)wp, w1 = *(const f32x4*)(wp + 4);
            qf[kk] = mk8(cvt_pk_bf16(qv[kk][0] * rs * w0[0], qv[kk][1] * rs * w0[1]), cvt_pk_bf16(qv[kk][2] * rs * w0[2], qv[kk][3] * rs * w0[3]),
                         cvt_pk_bf16(qv[kk][4] * rs * w1[0], qv[kk][5] * rs * w1[1]), cvt_pk_bf16(qv[kk][6] * rs * w1[2], qv[kk][7] * rs * w1[3])); }
    }
    const int kt_lo = (n >= 8) ? 0 : 8 - n;
    const int key = tid >> 3, sub = tid & 7, vd = tid >> 2, vpart = tid & 3;
    u32x4 nk0, nk1, nv0, nv1;
#define ATT_LOAD(kt_) do { const bf16_t* rp = P + (size_t)((n - 8 + (kt_)) * 64 + key) * NP + h * 128 + 16 * sub + P_AK; \
        const bf16_t* vq = P + (size_t)((n - 8 + (kt_)) * 64 + (vd >> 1)) * NP + P_AV + h * 128 + (vd & 1) * 64 + 16 * vpart; \
        nk0 = *(const u32x4*)(rp); nk1 = *(const u32x4*)(rp + 8); nv0 = *(const u32x4*)(vq); nv1 = *(const u32x4*)(vq + 8); } while (0)
    ATT_LOAD(kt_lo);
    f32x4 oacc[8];
#pragma unroll
    for (int dt = 0; dt < 8; ++dt) oacc[dt] = (f32x4){0.f, 0.f, 0.f, 0.f};
    float lsum = 0.f;
    for (int kt = kt_lo; kt < 9; ++kt) {
        {   *(LAS u32x4*)(KS + key * 136 + 16 * sub) = nk0; *(LAS u32x4*)(KS + key * 136 + 16 * sub + 8) = nk1;
            LAS bf16_t* vrow = VTS + vd * 68; const int dtw = vd >> 4, g0 = 4 * vpart;
            *(LAS u32x2*)(vrow + (((g0 + 0) ^ dtw) << 2)) = (u32x2){nv0.x, nv0.y}; *(LAS u32x2*)(vrow + (((g0 + 1) ^ dtw) << 2)) = (u32x2){nv0.z, nv0.w};
            *(LAS u32x2*)(vrow + (((g0 + 2) ^ dtw) << 2)) = (u32x2){nv1.x, nv1.y}; *(LAS u32x2*)(vrow + (((g0 + 3) ^ dtw) << 2)) = (u32x2){nv1.z, nv1.w};
        }
        BAR_LDS();
        if (kt + 1 < 9) ATT_LOAD(kt + 1);
        unsigned pk[2][2];
#pragma unroll
        for (int kt2 = 0; kt2 < 2; ++kt2) { const int kb = 32 * kh + 16 * kt2; f32x4 acc = {0.f, 0.f, 0.f, 0.f};
#pragma unroll
            for (int kk = 0; kk < 4; ++kk) { const bf16x8 a = *(const LAS bf16x8*)(KS + (kb + fr) * 136 + 32 * kk + 8 * fq); acc = MFMA16(a, qf[kk], acc); }
            float p[4];
#pragma unroll
            for (int r = 0; r < 4; ++r) { const int jband = 64 * kt + kb + 4 * fq + r; int rel = (16 * it + fr) - jband + 512; rel = rel < -63 ? -63 : (rel > 256 ? 256 : rel);
                p[r] = __builtin_amdgcn_exp2f(acc[r] + BIAS[rel + 63] - shift); lsum += p[r]; }
            pk[kt2][0] = cvt_pk_bf16(p[0], p[1]); pk[kt2][1] = cvt_pk_bf16(p[2], p[3]); }
        const bf16x8 pf = mk8(pk[0][0], pk[0][1], pk[1][0], pk[1][1]);
#pragma unroll
        for (int dt = 0; dt < 8; ++dt) { const LAS bf16_t* vrow = VTS + (16 * dt + fr) * 68; const int g0 = 8 * kh + fq;
            const u32x2 a0 = *(const LAS u32x2*)(vrow + (((g0) ^ dt) << 2)), a1 = *(const LAS u32x2*)(vrow + (((g0 + 4) ^ dt) << 2));
            oacc[dt] = MFMA16(mk8(a0.x, a0.y, a1.x, a1.y), pf, oacc[dt]); }
        BAR_LDS();
    }
#undef ATT_LOAD
    lsum += __shfl_xor(lsum, 16); lsum += __shfl_xor(lsum, 32);
    LAS float* CB = (LAS float*)lds;
    if (kh == 1) {
#pragma unroll
        for (int dt = 0; dt < 8; ++dt)
#pragma unroll
            for (int r = 0; r < 4; ++r) CB[(it * 33 + dt * 4 + r) * 64 + lane] = oacc[dt][r];
        CB[(it * 33 + 32) * 64 + lane] = lsum; }
    BAR_LDS();
    if (kh == 0) {
#pragma unroll
        for (int dt = 0; dt < 8; ++dt)
#pragma unroll
            for (int r = 0; r < 4; ++r) oacc[dt][r] += CB[(it * 33 + dt * 4 + r) * 64 + lane];
        lsum += CB[(it * 33 + 32) * 64 + lane];
        const float inv = 1.0f / lsum;
        bf16_t* op = OA + (size_t)(n * 64 + 16 * it + fr) * 1024 + h * 128 + 4 * fq;
#pragma unroll
        for (int dt = 0; dt < 8; ++dt) { u32x2 w; w.x = cvt_pk_bf16(oacc[dt][0] * inv, oacc[dt][1] * inv); w.y = cvt_pk_bf16(oacc[dt][2] * inv, oacc[dt][3] * inv); *(u32x2*)(op + 16 * dt) = w; }
    }
    BAR_LDS();
}
struct Args { const float* in[21]; float* out; unsigned char* ws; int ph_lo, ph_hi; };
constexpr int NPHASE = 11;
__global__ void __launch_bounds__(512, 2) hybrid_fwd(Args args) {
    extern __shared__ __attribute__((aligned(16))) unsigned char lds_raw[];
    LAS unsigned char* lds = (LAS unsigned char*)lds_raw;
    if (threadIdx.x < 16) ((LAS unsigned*)(lds + LDS_BYTES - 64))[threadIdx.x] = 0u;
    __syncthreads();
    XcdBarrier bar; bar.bar = nullptr; bar.x = 0; bar.st = nullptr;
    if (args.ph_hi - args.ph_lo > 1) bar = xcd_barrier_post((unsigned*)(args.ws + WS_BAR), (volatile LAS unsigned*)(lds + LDS_BYTES - 64));
    const int tid = threadIdx.x, lane = tid & 63, wave = __builtin_amdgcn_readfirstlane(tid >> 6);
    const int G = gridDim.x, bx = blockIdx.x;
    unsigned char* ws = args.ws; float* ctl = (float*)(ws + WS_CTL);
    bf16_t* XB = (bf16_t*)(ws + WS_XB); bf16_t* Pb = (bf16_t*)(ws + WS_P);
    float* xres = args.out;
    const int lo = args.ph_lo, hi = args.ph_hi;
#define IN(k) (lo <= (k) && (k) < hi)
#ifndef DUP_MASK
#define DUP_MASK 0
#endif
#define REP(k) for (int rep_ = 0; rep_ < (((DUP_MASK >> (k)) & 1) ? 2 : 1); ++rep_)
#define REPBAR() do { if (rep_) xcd_barrier(bar); } while (0)
#define SEAM(k) do { if (IN(k) && IN((k) + 1)) xcd_barrier(bar); } while (0)

    Ptrs A; for (int i = 0; i < 21; ++i) A.in[i] = args.in[i]; A.out = args.out; A.ws = ws;
    if (IN(0)) REP(0) { REPBAR(); p0_prologue(A, lds, bx, G); }
    SEAM(0);
    if (IN(1)) REP(1) { REPBAR();
        pg8::Gemm g{XB, (const bf16_t*)(ws + WS_WGU1), T, NGU, D}; pg8::StaticOrder S; S.init(T, NGU, G, bx);
        pg8::EpiSwiglu E{(bf16_t*)(ws + WS_ACT1), FF, ctl + CW_SS1};
        pg8::gemm_phase<pg8::EpiSwiglu, pg8::StaticOrder, true, true>(lds, g, S, E);
        if (LATE_CVT && bx >= 96 && G == 256) cvt_items(A, lds, (bx - 96) * 8 + wave, 160 * 8, R_DN1, R_IN, R_GU2, GU2_SPLIT);
    }
    SEAM(1);
    if (IN(2)) {
        pg8::Gemm g{(const bf16_t*)(ws + WS_ACT1), (const bf16_t*)(ws + WS_WD1), T, D, FF}; pg8::StaticOrder S; S.init(T, D, G, bx);
        pg8::EpiResid<true> E{args.in[0], xres, XB, ctl + CW_SS2, 0.5f};
        pg8::gemm_phase<pg8::EpiResid<true>, pg8::StaticOrder, false, true>(lds, g, S, E);
    }
    SEAM(2);
    if (IN(3)) REP(3) { REPBAR();
        pg8::Gemm g{XB, (const bf16_t*)(ws + WS_WIN), T, NINP, D}; pg8::StaticOrder S; S.init(T, NINP, G, bx);
        pg8::EpiP E{Pb, ctl + CW_AB, ctl + CW_SS2};
        pg8::gemm_phase<pg8::EpiP, pg8::StaticOrder, true, true>(lds, g, S, E);
        if (LATE_CVT && G == 256 && bx >= 160) cvt_items(A, lds, (bx - 160) * 8 + wave, 96 * 8, GU2_SPLIT, R_DN2, R_A, R_END);
    }
    SEAM(3);
#ifndef DBG_SKIP_GDN
    if (IN(4)) {
#ifdef PROBE_P4_MODE
        for (int u = bx; u < NCH * H; u += G)
            gdn_prep_unit<PROBE_P4_MODE>(lds, u >> 3, u & 7, Pb, ctl + CW_AB, args.in[7], args.in[8], args.in[9], args.in[12], (bf16_t*)(ws + WS_WN), (bf16_t*)(ws + WS_QG), (bf16_t*)(ws + WS_KDT),
                          (float*)(ws + WS_U), (bf16_t*)(ws + WS_AQK), ctl + CW_CD);
        xcd_barrier(bar);
#endif
        for (int u = bx; u < NCH * H; u += G)
            gdn_prep_unit(lds, u >> 3, u & 7, Pb, ctl + CW_AB, args.in[7], args.in[8], args.in[9], args.in[12], (bf16_t*)(ws + WS_WN), (bf16_t*)(ws + WS_QG), (bf16_t*)(ws + WS_KDT),
                          (float*)(ws + WS_U), (bf16_t*)(ws + WS_AQK), ctl + CW_CD);
    }
#endif
    SEAM(4);
#define P5_BODY(part_, late_) do { \
        if (bx < 64) { if ((part_) & 1) gdn_scan(lds, bx & 7, bx >> 3, (const bf16_t*)(ws + WS_WN), (const bf16_t*)(ws + WS_QG), (const bf16_t*)(ws + WS_KDT), (const float*)(ws + WS_U), (const bf16_t*)(ws + WS_AQK), \
                              ctl + CW_CD, (bf16_t*)(ws + WS_ORAW), 1024); \
            } \
        else if ((part_) & 2) { const float shift = ctl[CW_SHIFT]; \
            for (int u = bx - 64; u < NCH * H; u += G - 64) attn_unit(lds, u >> 3, u & 7, Pb, args.in[11], args.in[13], shift, (bf16_t*)(ws + WS_OA)); } } while (0)
    if (IN(5)) {
        P5_BODY(3, 1);
#ifdef PROBE_P5_PART
        xcd_barrier(bar); P5_BODY(PROBE_P5_PART, 0);
#endif
    }
    SEAM(5);
    if (IN(6)) REP(6) { REPBAR();
        const int gw = bx * 8 + wave, NGW = G * 8; const int hh = lane >> 3, d0 = (lane & 7) * 16;
        float wv[16]; ld16f(args.in[10] + d0, wv);
        bf16_t* OG = (bf16_t*)(ws + WS_OG);
        for (int row = gw; row < T; row += NGW) {
            float o[16], z[16];
#ifdef DBG_GDN_U
            ld16f((const float*)(ws + WS_U) + (size_t)row * 1024 + hh * 128 + d0, o);
#else
            ld16bf((const bf16_t*)(ws + WS_ORAW) + (size_t)row * 1024 + hh * 128 + d0, o);
#endif
            ld16bf(Pb + (size_t)row * NP + P_GZ + hh * 128 + d0, z);
            float ss = 0.f;
#pragma unroll
            for (int e = 0; e < 16; ++e) ss += o[e] * o[e];
            ss += __shfl_xor(ss, 1); ss += __shfl_xor(ss, 2); ss += __shfl_xor(ss, 4);
            const float rs = rsqrtf(ss * (1.0f / 128.0f) + EPS);
#pragma unroll
            for (int e = 0; e < 16; ++e) o[e] = o[e] * rs * wv[e] * siluf_(z[e]);
#ifdef DBG_SKIP_GDN
            for (int e = 0; e < 16; ++e) o[e] = 0.f;
#endif
            st16bf_g(OG + (size_t)row * 1024 + hh * 128 + d0, o);
        }
    }
    SEAM(6);
    if (IN(7)) REP(7) { REPBAR();
        bf16_t* Mb = (bf16_t*)(ws + WS_M);
        { pg8::Gemm g{(const bf16_t*)(ws + WS_OG), (const bf16_t*)(ws + WS_WA), T, D, 1024}; pg8::StaticOrder S; S.init(T, D, G, bx);
          pg8::EpiGate<0> E{Mb, Pb, P_G1}; pg8::gemm_phase<pg8::EpiGate<0>, pg8::StaticOrder, false, true>(lds, g, S, E); }
        { pg8::Gemm g{(const bf16_t*)(ws + WS_OA), (const bf16_t*)(ws + WS_WB), T, D, 1024}; pg8::StaticOrder S; S.init(T, D, G, bx);
          pg8::EpiGate<1> E{Mb, Pb, P_G2}; pg8::gemm_phase<pg8::EpiGate<1>, pg8::StaticOrder, false, true>(lds, g, S, E); }
    }
    SEAM(7);
    if (IN(8)) {
        pg8::Gemm g{(const bf16_t*)(ws + WS_M), (const bf16_t*)(ws + WS_WOUT), T, D, D}; pg8::StaticOrder S; S.init(T, D, G, bx);
        pg8::EpiResid<true> E{xres, xres, XB, ctl + CW_SS3, 1.0f};
        pg8::gemm_phase<pg8::EpiResid<true>, pg8::StaticOrder, false, true>(lds, g, S, E);
    }
    SEAM(8);
    if (IN(9)) REP(9) { REPBAR();
        pg8::Gemm g{XB, (const bf16_t*)(ws + WS_WGU2), T, NGU, D}; pg8::StaticOrder S; S.init(T, NGU, G, bx);
        pg8::EpiSwiglu E{(bf16_t*)(ws + WS_ACT2), FF, ctl + CW_SS3};
        pg8::gemm_phase<pg8::EpiSwiglu, pg8::StaticOrder, true, true>(lds, g, S, E);
        if (LATE_CVT && bx >= 96 && G == 256) cvt_items(A, lds, (bx - 96) * 8 + wave, 160 * 8, R_DN2, R_A);
    }
    SEAM(9);
    if (IN(10)) {
        pg8::Gemm g{(const bf16_t*)(ws + WS_ACT2), (const bf16_t*)(ws + WS_WD2), T, D, FF}; pg8::StaticOrder S; S.init(T, D, G, bx);
        pg8::EpiResid<false> E{xres, xres, nullptr, nullptr, 0.5f};
        pg8::gemm_phase<pg8::EpiResid<false>, pg8::StaticOrder, false, true>(lds, g, S, E);
    }
#undef IN
#undef SEAM
}

extern "C" void kernel_launch(void* const* d_in, const int* in_sizes, int n_in, void* d_out, int out_size, void* d_ws, size_t ws_size, hipStream_t stream) {
    static int grid = 0;
    if (grid == 0) {
        if (n_in != 21 || out_size != T * D || ws_size < WS_END) { fprintf(stderr, "kernel_launch: unexpected problem (n_in %d, out %d, ws %zu)\n", n_in, out_size, ws_size); grid = -1; return; }
        int dev = 0, cus = 0, per_cu = 0;
        if (hipGetDevice(&dev) != hipSuccess || hipDeviceGetAttribute(&cus, hipDeviceAttributeMultiprocessorCount, dev) != hipSuccess) { grid = -1; return; }
        if (hipFuncSetAttribute((const void*)hybrid_fwd, hipFuncAttributeMaxDynamicSharedMemorySize, LDS_BYTES) != hipSuccess) { fprintf(stderr, "kernel_launch: hipFuncSetAttribute failed\n"); grid = -1; return; }
        if (hipOccupancyMaxActiveBlocksPerMultiprocessor(&per_cu, (const void*)hybrid_fwd, 512, LDS_BYTES) != hipSuccess || per_cu < 1) { fprintf(stderr, "kernel_launch: occupancy query says %d\n", per_cu); per_cu = 1; }
        (void)hipGetLastError();
        grid = cus;
    }
    if (grid < 0) return;
    if (hipMemsetAsync((char*)d_ws + WS_BAR, 0, 16384, stream) != hipSuccess) { fprintf(stderr, "kernel_launch: hipMemsetAsync failed\n"); return; }
    Args a{};
    for (int i = 0; i < 21; ++i) a.in[i] = (const float*)d_in[i];
    a.out = (float*)d_out; a.ws = (unsigned char*)d_ws;
#if N_LAUNCH == 1
    a.ph_lo = 0; a.ph_hi = NPHASE;
    void* kargs[] = {&a};
    hipError_t e = hipLaunchCooperativeKernel((const void*)hybrid_fwd, dim3(grid), dim3(512), kargs, LDS_BYTES, stream);
    if (e != hipSuccess) fprintf(stderr, "cooperative launch failed: %s (grid %d)\n", hipGetErrorString(e), grid);
#else
    for (int ph = 0; ph < NPHASE; ++ph) { a.ph_lo = ph; a.ph_hi = ph + 1; hipLaunchKernelGGL(hybrid_fwd, dim3(grid), dim3(512), LDS_BYTES, stream, a); }
#endif
}
```

```cpp
#include <hip/hip_runtime.h>
#include <hip/hip_cooperative_groups.h>
#include <cstdio>
#include <cstdint>
namespace cg = cooperative_groups;
namespace pg8 {
#define PG8_LAS __attribute__((address_space(3)))
typedef unsigned short bf16_t;
typedef short bf16x8 __attribute__((ext_vector_type(8)));
typedef float f32x4 __attribute__((ext_vector_type(4)));
typedef unsigned u32x4 __attribute__((ext_vector_type(4)));
constexpr int BM = 256, BK = 64, HALF = 128, HTB = HALF * BK * 2  , STAGE_BYTES = 8 * HTB, NXCD = 8, WGM = 8;

__host__ __device__ __forceinline__ int lds_byte(int r, int c) { const int st = (r >> 4) * 2 + (c >> 5), rr = r & 15, cc = c & 31, ob = rr * 64 + cc * 2; return st * 1024 + (ob ^ (((ob >> 9) & 1) << 5)); }
__host__ __device__ __forceinline__ void stage_rc(int b, int& R, int& C) { const int st = b / 1024, sb = b % 1024, swz = sb ^ (((sb >> 9) & 1) << 5); R = (st >> 1) * 16 + swz / 64; C = (st & 1) * 32 + (swz % 64) / 2; }
__host__ __device__ __forceinline__ int perm32(int rho) { const int n = rho >> 4, i = rho & 15; return 8 * (i >> 2) + 4 * n + (i & 3); }

struct Unit { int pm, pn; };
struct Gemm { const bf16_t* A; const bf16_t* Bt; int M, N, K; };

struct StaticOrder {
    int nM, nN, nwg, G, c;
    __host__ __device__ void init(int M, int N, int G_, int c_) { nM = M / BM; nN = N / BM; nwg = nM * nN; G = G_; c = c_; }
    __host__ __device__ bool next(int i, Unit& u) const {
        const long L = (long)i * G + c; if (L >= nwg) return false;
        int wgid = (int)L; { const int q = nwg / NXCD, r = nwg % NXCD, xcd = wgid % NXCD, off = wgid / NXCD; wgid = (xcd < r ? xcd * (q + 1) : r * (q + 1) + (xcd - r) * q) + off; }
        const int nig = WGM * nN, gid = wgid / nig, fm = gid * WGM, gsz = (nM - fm) < WGM ? (nM - fm) : WGM;
        u.pm = fm + ((wgid % nig) % gsz); u.pn = (wgid % nig) / gsz; return true;
    }
    __device__ __forceinline__ void a_ready(const Unit&) const {}
    __device__ __forceinline__ void done(const Unit&) const {}
};
typedef unsigned u32x2 __attribute__((ext_vector_type(2)));

typedef float f32x2_t __attribute__((ext_vector_type(2))); typedef __bf16 bf16x2_t __attribute__((ext_vector_type(2)));
__device__ __forceinline__ unsigned cvt_pk_bf16(float lo, float hi) { const f32x2_t v = {lo, hi}; const bf16x2_t b = __builtin_convertvector(v, bf16x2_t); return __builtin_bit_cast(unsigned, b); }
__device__ __forceinline__ float bf_lo(unsigned u) { return __uint_as_float(u << 16); }
__device__ __forceinline__ float bf_hi(unsigned u) { return __uint_as_float(u & 0xffff0000u); }
__device__ __forceinline__ float sigmoidf_(float x) { return __builtin_amdgcn_rcpf(1.0f + __expf(-x)); }
__device__ __forceinline__ float siluf_(float x) { return x * sigmoidf_(x); }
constexpr float NORM_EPS = 1e-6f;
constexpr int DM = 2048;
constexpr int NP = 11328;

typedef float f32x2 __attribute__((ext_vector_type(2)));
__device__ __forceinline__ f32x2 swiglu_pk(f32x2 g, f32x2 u, float rs) {
    const f32x2 gs = g * rs, us = u * rs, t = gs * (-1.4426950408889634f);
    f32x2 e; e.x = __builtin_amdgcn_exp2f(t.x); e.y = __builtin_amdgcn_exp2f(t.y);
    const f32x2 d = e + 1.0f;
    f32x2 r; r.x = __builtin_amdgcn_rcpf(d.x); r.y = __builtin_amdgcn_rcpf(d.y);
    return (gs * r) * us;
}
struct EpiSwiglu {
    static constexpr bool PERM = true, AFTER_DRAIN = false;
    bf16_t* O; int ldc; const float* rowss;
    __device__ __forceinline__ void operator()(const f32x4 (&acc)[2][2][4][2], const Unit& u, int wr, int wc, int fr, int fq) const {
        const int row0 = u.pm * BM + wr * 64 + fr; const int col0 = u.pn * 128 + wc * 32 + 8 * fq;
#pragma unroll
        for (int ai = 0; ai < 2; ++ai)
#pragma unroll
            for (int m = 0; m < 4; ++m) { const int row = row0 + ai * HALF + m * 16; const float rs = rsqrtf(rowss[row] * (1.0f / DM) + NORM_EPS);
                const f32x4 g0 = acc[ai][0][m][0], g1 = acc[ai][0][m][1], u0 = acc[ai][1][m][0], u1 = acc[ai][1][m][1];
                const f32x2 a = swiglu_pk((f32x2){g0[0], g0[1]}, (f32x2){u0[0], u0[1]}, rs), b = swiglu_pk((f32x2){g0[2], g0[3]}, (f32x2){u0[2], u0[3]}, rs);
                const f32x2 c = swiglu_pk((f32x2){g1[0], g1[1]}, (f32x2){u1[0], u1[1]}, rs), d = swiglu_pk((f32x2){g1[2], g1[3]}, (f32x2){u1[2], u1[3]}, rs);
                u32x4 w; w.x = cvt_pk_bf16(a.x, a.y); w.y = cvt_pk_bf16(b.x, b.y); w.z = cvt_pk_bf16(c.x, c.y); w.w = cvt_pk_bf16(d.x, d.y);
                *(u32x4*)(O + (size_t)row * ldc + col0) = w; }
    }
};
struct EpiP {
    static constexpr bool PERM = true, AFTER_DRAIN = false;
    bf16_t* P; float* AB; const float* rowss;
    __device__ __forceinline__ void operator()(const f32x4 (&acc)[2][2][4][2], const Unit& u, int wr, int wc, int fr, int fq) const {
        const int row0 = u.pm * BM + wr * 64 + fr;
        if (u.pn < 44) { const int col0 = u.pn * BM + wc * 32 + 8 * fq;
#pragma unroll
            for (int ai = 0; ai < 2; ++ai)
#pragma unroll
                for (int m = 0; m < 4; ++m) { const int row = row0 + ai * HALF + m * 16; const float rs = rsqrtf(rowss[row] * (1.0f / DM) + NORM_EPS);
#pragma unroll
                    for (int bj = 0; bj < 2; ++bj) { const f32x4 v0 = acc[ai][bj][m][0] * rs, v1 = acc[ai][bj][m][1] * rs;
                        u32x4 w; w.x = cvt_pk_bf16(v0[0], v0[1]); w.y = cvt_pk_bf16(v0[2], v0[3]); w.z = cvt_pk_bf16(v1[0], v1[1]); w.w = cvt_pk_bf16(v1[2], v1[3]);
                        *(u32x4*)(P + (size_t)row * NP + col0 + bj * HALF) = w; } }
        } else if (wc == 0 && fq < 2) {
#pragma unroll
            for (int ai = 0; ai < 2; ++ai)
#pragma unroll
                for (int m = 0; m < 4; ++m) { const int row = row0 + ai * HALF + m * 16; const float rs = rsqrtf(rowss[row] * (1.0f / DM) + NORM_EPS);
                    *(f32x4*)(AB + (size_t)row * 16 + 8 * fq) = acc[ai][0][m][0] * rs; *(f32x4*)(AB + (size_t)row * 16 + 8 * fq + 4) = acc[ai][0][m][1] * rs; }
        }
    }
};
template <int WHICH> struct EpiGate {
    static constexpr bool PERM = true, AFTER_DRAIN = false;
    bf16_t* Mo; const bf16_t* P; int goff;
    __device__ __forceinline__ void operator()(const f32x4 (&acc)[2][2][4][2], const Unit& u, int wr, int wc, int fr, int fq) const {
        const int row0 = u.pm * BM + wr * 64 + fr; const int col0 = u.pn * BM + wc * 32 + 8 * fq;
#pragma unroll
        for (int ai = 0; ai < 2; ++ai)
#pragma unroll
            for (int m = 0; m < 4; ++m) { const int row = row0 + ai * HALF + m * 16;
#pragma unroll
                for (int bj = 0; bj < 2; ++bj) { const int col = col0 + bj * HALF;
                    const u32x4 g = *(const u32x4*)(P + (size_t)row * NP + goff + col);
                    const f32x4 a0 = acc[ai][bj][m][0], a1 = acc[ai][bj][m][1];
                    float v[8];
                    v[0] = sigmoidf_(bf_lo(g.x)) * a0[0]; v[1] = sigmoidf_(bf_hi(g.x)) * a0[1]; v[2] = sigmoidf_(bf_lo(g.y)) * a0[2]; v[3] = sigmoidf_(bf_hi(g.y)) * a0[3];
                    v[4] = sigmoidf_(bf_lo(g.z)) * a1[0]; v[5] = sigmoidf_(bf_hi(g.z)) * a1[1]; v[6] = sigmoidf_(bf_lo(g.w)) * a1[2]; v[7] = sigmoidf_(bf_hi(g.w)) * a1[3];
                    bf16_t* op = Mo + (size_t)row * DM + col;
                    if (WHICH == 1) { const u32x4 o = *(const u32x4*)op;
                        v[0] += bf_lo(o.x); v[1] += bf_hi(o.x); v[2] += bf_lo(o.y); v[3] += bf_hi(o.y); v[4] += bf_lo(o.z); v[5] += bf_hi(o.z); v[6] += bf_lo(o.w); v[7] += bf_hi(o.w); }
                    u32x4 w; w.x = cvt_pk_bf16(v[0], v[1]); w.y = cvt_pk_bf16(v[2], v[3]); w.z = cvt_pk_bf16(v[4], v[5]); w.w = cvt_pk_bf16(v[6], v[7]);
                    *(u32x4*)op = w; } }
    }
};
template <bool BF> struct EpiResid {
    static constexpr bool PERM = false, AFTER_DRAIN = false;
    const float* R; float* out; bf16_t* XB; float* rowss; float scale;
    __device__ __forceinline__ void operator()(const f32x4 (&acc)[2][2][4][2], const Unit& u, int wr, int wc, int fr, int fq) const {
        const int row0 = u.pm * BM + wr * 64 + fr; const int col0 = u.pn * BM + wc * 32 + 4 * fq;
#pragma unroll
        for (int ai = 0; ai < 2; ++ai)
#pragma unroll
            for (int m = 0; m < 4; ++m) { const int row = row0 + ai * HALF + m * 16; float ss = 0.f;
#pragma unroll
                for (int bj = 0; bj < 2; ++bj)
#pragma unroll
                    for (int n = 0; n < 2; ++n) { const size_t off = (size_t)row * DM + col0 + bj * HALF + n * 16;
                        const f32x4 r = *(const f32x4*)(R + off); const f32x4 y = r + acc[ai][bj][m][n] * scale;
                        *(f32x4*)(out + off) = y;
                        if (BF) { u32x2 w; w.x = cvt_pk_bf16(y[0], y[1]); w.y = cvt_pk_bf16(y[2], y[3]); *(u32x2*)(XB + off) = w; ss += (y[0] * y[0] + y[1] * y[1]) + (y[2] * y[2] + y[3] * y[3]); } }
                if (BF) { ss += __shfl_xor(ss, 16); ss += __shfl_xor(ss, 32); if (fq == 0) atomicAdd(rowss + row, ss); } }
    }
};

template <class Epi, class Sched, bool ALIGN_EPI = false, bool SP2 = false>
__device__ __forceinline__ void gemm_phase(PG8_LAS unsigned char* lds, const Gemm g, const Sched& S, const Epi& E) {
    const int tid = threadIdx.x, wid = __builtin_amdgcn_readfirstlane(tid >> 6), lane = tid & 63, wr = wid >> 2, wc = wid & 3, fr = lane & 15, fq = lane >> 4;
    const int K = g.K, nt = K / BK;
    unsigned voffA[2], voffB[2];
#pragma unroll
    for (int i = 0; i < 2; ++i) { int R, C; stage_rc(tid * 16 + i * 8192, R, C); const int Rb = Epi::PERM ? ((R & ~31) + perm32(R & 31)) : R;
        voffA[i] = (unsigned)(R * K + C) * 2u; voffB[i] = (unsigned)(Rb * K + C) * 2u; }
    const size_t kstep = (size_t)(BK * 2);
    const size_t hstep = (size_t)HALF * K * 2;
    const size_t tstep = 2 * hstep;
    const unsigned ldsw = (unsigned)wid * 1024u;
    const int aoff = lds_byte(wr * 64 + fr, fq * 8), boff = lds_byte(wc * 32 + fr, fq * 8);
#define PG8_SA(b, h) (((b) * 2 + (h)) * HTB)
#define PG8_SB(b, h) ((4 + (b) * 2 + (h)) * HTB)
#define PG8_STAGE(bufoff, gbase, voff) do { _Pragma("unroll") for (int _i = 0; _i < 2; ++_i) \
        __builtin_amdgcn_global_load_lds((const unsigned*)((const char*)(gbase) + (voff)[_i]), (PG8_LAS unsigned*)(lds + (bufoff) + ldsw + _i * 8192), 16, 0, 0); } while (0)
#define PG8_LDA(dst, b, h) do { _Pragma("unroll") for (int m = 0; m < 4; ++m) _Pragma("unroll") for (int k = 0; k < 2; ++k) dst[m][k] = *(const PG8_LAS bf16x8*)(lds + PG8_SA(b, h) + aoff + m * 2048 + k * 1024); } while (0)
#define PG8_LDB(dst, b, h) do { _Pragma("unroll") for (int n = 0; n < 2; ++n) _Pragma("unroll") for (int k = 0; k < 2; ++k) dst[n][k] = *(const PG8_LAS bf16x8*)(lds + PG8_SB(b, h) + boff + n * 2048 + k * 1024); } while (0)
#define PG8_MMA(ai, bj, At, Bt) do { __builtin_amdgcn_s_setprio(1); _Pragma("unroll") for (int m = 0; m < 4; ++m) _Pragma("unroll") for (int n = 0; n < 2; ++n) _Pragma("unroll") for (int k = 0; k < 2; ++k) \
        acc[ai][bj][m][n] = __builtin_amdgcn_mfma_f32_16x16x32_bf16(Bt[n][k], At[m][k], acc[ai][bj][m][n], 0, 0, 0); __builtin_amdgcn_s_setprio(0); } while (0)
#define PG8_WAIT_V(n) asm volatile("s_waitcnt vmcnt(" #n ")" ::: "memory")
#define PG8_WAIT_L(n) asm volatile("s_waitcnt lgkmcnt(" #n ")" ::: "memory")
#define PG8_BAR __builtin_amdgcn_s_barrier()
#define PG8_SCHED __builtin_amdgcn_sched_barrier(0)
    Unit cur, nxt; int ui = 0;
    if (!S.next(0, cur)) return;
    f32x4 acc[2][2][4][2];
#pragma unroll
    for (int a = 0; a < 2; ++a)
#pragma unroll
        for (int b = 0; b < 2; ++b)
#pragma unroll
            for (int m = 0; m < 4; ++m)
#pragma unroll
                for (int n = 0; n < 2; ++n) acc[a][b][m][n] = (f32x4){0.f, 0.f, 0.f, 0.f};
    bf16x8 At[4][2], B0[2][2], B1[2][2];
    const char* cA = (const char*)g.A + (size_t)cur.pm * tstep; const char* cB = (const char*)g.Bt + (size_t)cur.pn * tstep;
    S.a_ready(cur);
    if constexpr (SP2) {
        PG8_STAGE(PG8_SB(0, 0), cB, voffB); PG8_STAGE(PG8_SB(0, 1), cB + hstep, voffB); PG8_STAGE(PG8_SA(0, 0), cA, voffA); PG8_STAGE(PG8_SA(0, 1), cA + hstep, voffA);
        if (wr == 1) PG8_BAR;
        PG8_WAIT_V(2); PG8_BAR;
        PG8_STAGE(PG8_SB(1, 0), cB + kstep, voffB); PG8_STAGE(PG8_SA(1, 0), cA + kstep, voffA); PG8_STAGE(PG8_SB(1, 1), cB + hstep + kstep, voffB);
        PG8_WAIT_V(6); PG8_BAR;
    } else {
        PG8_STAGE(PG8_SB(0, 0), cB, voffB); PG8_STAGE(PG8_SA(0, 0), cA, voffA); PG8_STAGE(PG8_SB(0, 1), cB + hstep, voffB); PG8_STAGE(PG8_SA(0, 1), cA + hstep, voffA);
        if (wr == 1) PG8_BAR;
        PG8_WAIT_V(4); PG8_BAR;
        PG8_STAGE(PG8_SB(1, 0), cB + kstep, voffB); PG8_STAGE(PG8_SA(1, 0), cA + kstep, voffA); PG8_STAGE(PG8_SB(1, 1), cB + hstep + kstep, voffB);
        PG8_WAIT_V(6); PG8_BAR;
    }
    for (;;) {
        const bool has_next = S.next(ui + 1, nxt);
        const char* nA = has_next ? (const char*)g.A + (size_t)nxt.pm * tstep : cA; const char* nB = has_next ? (const char*)g.Bt + (size_t)nxt.pn * tstep : cB;
        for (int t = 0; t < nt; t += 2) {
            const bool last = (t == nt - 2);
            const char* a1 = cA + (size_t)(t + 1) * kstep;
            const char* a2 = last ? nA : cA + (size_t)(t + 2) * kstep; const char* b2 = last ? nB : cB + (size_t)(t + 2) * kstep;
            const char* a3 = a2 + kstep; const char* b3 = b2 + kstep;
            if (last && has_next) S.a_ready(nxt);
            if constexpr (SP2) {
            PG8_LDB(B0, 0, 0); PG8_LDB(B1, 0, 1); PG8_SCHED; PG8_LDA(At, 0, 0); PG8_STAGE(PG8_SA(1, 1), a1 + hstep, voffA);
            PG8_WAIT_V(8); PG8_WAIT_L(0); PG8_BAR; PG8_MMA(0, 0, At, B0); PG8_MMA(0, 1, At, B1); PG8_BAR; PG8_SCHED;
            PG8_LDA(At, 0, 1); PG8_STAGE(PG8_SB(0, 0), b2, voffB); PG8_STAGE(PG8_SB(0, 1), b2 + hstep, voffB); PG8_STAGE(PG8_SA(0, 0), a2, voffA);
            PG8_WAIT_V(8); PG8_WAIT_L(0); PG8_BAR; PG8_MMA(1, 0, At, B0); PG8_MMA(1, 1, At, B1); PG8_BAR; PG8_SCHED;
            PG8_LDB(B0, 1, 0); PG8_LDB(B1, 1, 1); PG8_SCHED; PG8_LDA(At, 1, 0); PG8_STAGE(PG8_SA(0, 1), a2 + hstep, voffA);
            PG8_WAIT_V(8); PG8_WAIT_L(0); PG8_BAR; PG8_MMA(0, 0, At, B0); PG8_MMA(0, 1, At, B1); PG8_BAR; PG8_SCHED;
            PG8_LDA(At, 1, 1); PG8_STAGE(PG8_SB(1, 0), b3, voffB); PG8_STAGE(PG8_SB(1, 1), b3 + hstep, voffB); PG8_STAGE(PG8_SA(1, 0), a3, voffA);
            PG8_WAIT_V(8); PG8_WAIT_L(0); PG8_BAR; PG8_MMA(1, 0, At, B0); PG8_MMA(1, 1, At, B1); PG8_BAR; PG8_SCHED;
            } else {
            PG8_LDB(B0, 0, 0); PG8_SCHED; PG8_LDA(At, 0, 0); PG8_STAGE(PG8_SA(1, 1), a1 + hstep, voffA);
            PG8_WAIT_L(8); PG8_BAR; PG8_WAIT_L(0); PG8_MMA(0, 0, At, B0); PG8_BAR; PG8_SCHED;
            PG8_LDB(B1, 0, 1); PG8_STAGE(PG8_SB(0, 0), b2, voffB);
            PG8_BAR; PG8_WAIT_L(0); PG8_MMA(0, 1, At, B1); PG8_BAR;
            PG8_LDA(At, 0, 1); PG8_STAGE(PG8_SA(0, 0), a2, voffA);
            PG8_BAR; PG8_WAIT_L(0); PG8_MMA(1, 0, At, B0); PG8_BAR; PG8_SCHED;
            PG8_STAGE(PG8_SB(0, 1), b2 + hstep, voffB);
            PG8_WAIT_V(6); PG8_BAR; PG8_MMA(1, 1, At, B1); PG8_BAR;
            PG8_LDB(B0, 1, 0); PG8_SCHED; PG8_LDA(At, 1, 0); PG8_STAGE(PG8_SA(0, 1), a2 + hstep, voffA);
            PG8_WAIT_L(8); PG8_BAR; PG8_WAIT_L(0); PG8_MMA(0, 0, At, B0); PG8_BAR; PG8_SCHED;
            PG8_LDB(B1, 1, 1); PG8_STAGE(PG8_SB(1, 0), b3, voffB);
            PG8_BAR; PG8_WAIT_L(0); PG8_MMA(0, 1, At, B1); PG8_BAR;
            PG8_LDA(At, 1, 1); PG8_STAGE(PG8_SA(1, 0), a3, voffA);
            PG8_BAR; PG8_WAIT_L(0); PG8_MMA(1, 0, At, B0); PG8_BAR; PG8_SCHED;
            PG8_STAGE(PG8_SB(1, 1), b3 + hstep, voffB);
            PG8_WAIT_V(6); PG8_BAR; PG8_MMA(1, 1, At, B1); PG8_BAR;
            }
        }
        if constexpr (ALIGN_EPI) { if (wr == 0) PG8_BAR; }
        if constexpr (!Epi::AFTER_DRAIN) { E(acc, cur, wr, wc, fr, fq); S.done(cur); }
        if (!has_next) break;
#pragma unroll
        for (int a = 0; a < 2; ++a)
#pragma unroll
            for (int b = 0; b < 2; ++b)
#pragma unroll
                for (int m = 0; m < 4; ++m)
#pragma unroll
                    for (int n = 0; n < 2; ++n) acc[a][b][m][n] = (f32x4){0.f, 0.f, 0.f, 0.f};
        cur = nxt; cA = nA; cB = nB; ++ui;
        if constexpr (ALIGN_EPI) { if (wr == 1) PG8_BAR; }
    }
    PG8_WAIT_V(0);
    if constexpr (!ALIGN_EPI) { if (wr == 0) PG8_BAR; }
    PG8_BAR;
    if constexpr (Epi::AFTER_DRAIN) { E.fused(acc, cur, wr, wc, fr, fq, lds, wid, lane); S.done(cur); }
#undef PG8_SA
#undef PG8_SB
#undef PG8_STAGE
#undef PG8_LDA
#undef PG8_LDB
#undef PG8_MMA
#undef PG8_WAIT_V
#undef PG8_WAIT_L
#undef PG8_BAR
#undef PG8_SCHED
}
}
#define LAS __attribute__((address_space(3)))
using pg8::bf16_t; using pg8::bf16x8; using pg8::f32x4; using pg8::u32x4; using pg8::u32x2; using pg8::cvt_pk_bf16; using pg8::bf_lo; using pg8::bf_hi; using pg8::siluf_;
#ifndef LATE_CVT
#define LATE_CVT 1
#endif
#ifndef N_LAUNCH
#define N_LAUNCH 1
#endif
constexpr int T = 8192, D = 2048, FF = 5504, NGU = 11008, NP = pg8::NP, NINP = 11520, H = 8, NCH = 128;
constexpr int P_GQ = 0, P_GK = 1024, P_GV = 2048, P_GZ = 3072, P_AQ = 4096, P_AK = 5120, P_AV = 6144, P_G1 = 7168, P_G2 = 9216;
constexpr float EPS = 1e-6f, L2E = 1.4426950408889634f;
constexpr size_t MiB = 1u << 20;
constexpr size_t WS_CTL = 0;
constexpr size_t WS_WIN = 1 * MiB, WS_WA = 46 * MiB, WS_WB = 50 * MiB, WS_WOUT = 54 * MiB, WS_WGU2 = 62 * MiB, WS_WD2 = 105 * MiB;
constexpr size_t WS_XB = 127 * MiB, WS_OG = 127 * MiB, WS_OA = 143 * MiB;
constexpr size_t WS_P = 159 * MiB;
constexpr size_t WS_WGU1 = 159 * MiB, WS_WD1 = 202 * MiB, WS_ACT1 = 224 * MiB, WS_ACT2 = 159 * MiB;
constexpr size_t WS_WN = 336 * MiB, WS_QG = 352 * MiB, WS_KDT = 368 * MiB, WS_U = 384 * MiB, WS_AQK = 416 * MiB, WS_M = 336 * MiB, WS_ORAW = 424 * MiB, WS_END = 440 * MiB;
constexpr int CW_SS1 = 0, CW_SS2 = 8192, CW_SS3 = 16384, CW_CD = 24576, CW_SHIFT = 25600, CW_AB = 32768;
constexpr int LDS_BYTES = 147456;
constexpr size_t WS_BAR = 768 * 1024;

#define LDS_WAIT() asm volatile("s_waitcnt lgkmcnt(0)" ::: "memory")
#define BAR_LDS() asm volatile("s_waitcnt lgkmcnt(0)\n\ts_barrier" ::: "memory")
__device__ __forceinline__ float wave_sum(float v) {
#pragma unroll
    for (int o = 1; o < 64; o <<= 1) v += __shfl_xor(v, o);
    return v;
}
__device__ __forceinline__ bf16_t f2bf1(float x) { return (bf16_t)(cvt_pk_bf16(x, 0.f) & 0xffffu); }
__device__ __forceinline__ void unpack16(const u32x4 a, const u32x4 b, float (&o)[16]) {
    o[0] = bf_lo(a.x); o[1] = bf_hi(a.x); o[2] = bf_lo(a.y); o[3] = bf_hi(a.y); o[4] = bf_lo(a.z); o[5] = bf_hi(a.z); o[6] = bf_lo(a.w); o[7] = bf_hi(a.w);
    o[8] = bf_lo(b.x); o[9] = bf_hi(b.x); o[10] = bf_lo(b.y); o[11] = bf_hi(b.y); o[12] = bf_lo(b.z); o[13] = bf_hi(b.z); o[14] = bf_lo(b.w); o[15] = bf_hi(b.w);
}
__device__ __forceinline__ void ld16bf(const bf16_t* p, float (&o)[16]) { unpack16(*(const u32x4*)p, *(const u32x4*)(p + 8), o); }
__device__ __forceinline__ void ld16f(const float* p, float (&o)[16]) {
#pragma unroll
    for (int e = 0; e < 4; ++e) { const f32x4 w = *(const f32x4*)(p + 4 * e); o[4 * e] = w[0]; o[4 * e + 1] = w[1]; o[4 * e + 2] = w[2]; o[4 * e + 3] = w[3]; }
}
__device__ __forceinline__ void pack16(const float (&v)[16], u32x4& a, u32x4& b) {
    a.x = cvt_pk_bf16(v[0], v[1]); a.y = cvt_pk_bf16(v[2], v[3]); a.z = cvt_pk_bf16(v[4], v[5]); a.w = cvt_pk_bf16(v[6], v[7]);
    b.x = cvt_pk_bf16(v[8], v[9]); b.y = cvt_pk_bf16(v[10], v[11]); b.z = cvt_pk_bf16(v[12], v[13]); b.w = cvt_pk_bf16(v[14], v[15]);
}
__device__ __forceinline__ void st16bf_g(bf16_t* p, const float (&v)[16]) { u32x4 a, b; pack16(v, a, b); *(u32x4*)p = a; *(u32x4*)(p + 8) = b; }
__device__ __forceinline__ void st16bf_l(LAS bf16_t* p, const float (&v)[16]) { u32x4 a, b; pack16(v, a, b); *(LAS u32x4*)p = a; *(LAS u32x4*)(p + 8) = b; }
__device__ __forceinline__ bf16x8 mk8(unsigned a, unsigned b, unsigned c, unsigned d) { const u32x4 w = {a, b, c, d}; return __builtin_bit_cast(bf16x8, w); }
#define MFMA16(a, b, c) __builtin_amdgcn_mfma_f32_16x16x32_bf16((a), (b), (c), 0, 0, 0)
typedef short bf16x4 __attribute__((ext_vector_type(4)));
#define MFMA16K16(a, b, c) __builtin_amdgcn_mfma_f32_16x16x16bf16_1k((a), (b), (c), 0, 0, 0)
__device__ __forceinline__ bf16x4 mk4(float a, float b, float c, float d) { const u32x2 w = {cvt_pk_bf16(a, b), cvt_pk_bf16(c, d)}; return __builtin_bit_cast(bf16x4, w); }

struct CvtDesc { const float* W; bf16_t* WT; const float* ks; int ldN, srcn0, nvalid, K, k0, dstrow0; };
template <bool NT> __device__ __forceinline__ void cvt_load(const CvtDesc& d, int lane, f32x4 (&v)[16]) {
    const int kr = lane >> 4, nc = (lane & 15) * 4;
#pragma unroll
    for (int i = 0; i < 16; ++i) { const int k = i * 4 + kr; const f32x4* src = (const f32x4*)(d.W + (size_t)(d.k0 + k) * d.ldN + d.srcn0 + nc);
        v[i] = (nc < d.nvalid) ? (NT ? __builtin_nontemporal_load(src) : *src) : (f32x4){0.f, 0.f, 0.f, 0.f}; }
}
template <bool NT> __device__ __forceinline__ void cvt_store(const CvtDesc& d, const f32x4 (&v)[16], LAS float* scr, int lane) {
    const int kr = lane >> 4, nc = (lane & 15) * 4;
#pragma unroll
    for (int i = 0; i < 16; ++i) { const int k = i * 4 + kr; const float s = d.ks ? d.ks[d.k0 + k] : 1.f; LAS float* p = scr + k * 65 + nc;
        p[0] = v[i][0] * s; p[1] = v[i][1] * s; p[2] = v[i][2] * s; p[3] = v[i][3] * s; }
    LDS_WAIT();
    const int c = lane & 7, nrow = lane >> 3;
#pragma unroll
    for (int j = 0; j < 8; ++j) { const int n = j * 8 + nrow; const LAS float* s = scr + (8 * c) * 65 + n;
        u32x4 o; o.x = cvt_pk_bf16(s[0], s[65]); o.y = cvt_pk_bf16(s[130], s[195]); o.z = cvt_pk_bf16(s[260], s[325]); o.w = cvt_pk_bf16(s[390], s[455]);
        u32x4* dst = (u32x4*)(d.WT + (size_t)(d.dstrow0 + n) * d.K + d.k0 + 8 * c);
        if (NT) __builtin_nontemporal_store(o, dst); else *dst = o; }
    LDS_WAIT();
}
struct Ptrs {
    const float* in[21]; float* out; unsigned char* ws;
};
constexpr int I_GU = 32 * 172, I_DN = 86 * 32, I_IN = 32 * 180, I_AB = 16 * 32, I_OUT = 32 * 32;
constexpr int NITEMS = 2 * (I_GU + I_DN) + I_IN + 2 * I_AB + I_OUT, N_EARLY = I_GU + I_DN + I_IN, N_LATE1 = 6200;
constexpr int R_GU1 = 0, R_DN1 = I_GU, R_IN = R_DN1 + I_DN, R_GU2 = R_IN + I_IN, R_DN2 = R_GU2 + I_GU, R_A = R_DN2 + I_DN, R_END = NITEMS;
constexpr int IN_SPLIT = R_GU2 - 2048;
constexpr int GU2_SPLIT = R_GU2 + 1400;
__device__ __forceinline__ CvtDesc cvt_gu_desc(int r, const float* Wg, const float* Wu, const float* nrm, bf16_t* WT) {
    const int kb = r % 32, nb = r / 32, pn = nb >> 2, half = (nb & 3) >> 1, j0 = (nb & 1) * 64;
    return CvtDesc{half ? Wu : Wg, WT, nrm, FF, pn * 128 + j0, 64, D, kb * 64, nb * 64};
}
__device__ __forceinline__ CvtDesc cvt_decode(const Ptrs& A, int it) {
    unsigned char* ws = A.ws; int r = it;
    if (r < I_GU) return cvt_gu_desc(r, A.in[2], A.in[3], A.in[1], (bf16_t*)(ws + WS_WGU1)); r -= I_GU;
    if (r < I_DN) return CvtDesc{A.in[4], (bf16_t*)(ws + WS_WD1), nullptr, D, (r / 86) * 64, 64, FF, (r % 86) * 64, (r / 86) * 64}; r -= I_DN;
    if (r < I_IN) { const int kb = r % 32, nb = r / 32, c0 = nb * 64; int src, nv;
        if (c0 < 4096) { src = c0; nv = 64; } else if (c0 < 11264) { src = c0 + 16; nv = 64; } else if (c0 == 11264) { src = 4096; nv = 16; } else { src = 0; nv = 0; }
        return CvtDesc{A.in[6], (bf16_t*)(ws + WS_WIN), A.in[5], 11280, src, nv, D, kb * 64, c0}; } r -= I_IN;
    if (r < I_GU) return cvt_gu_desc(r, A.in[18], A.in[19], A.in[17], (bf16_t*)(ws + WS_WGU2)); r -= I_GU;
    if (r < I_DN) return CvtDesc{A.in[20], (bf16_t*)(ws + WS_WD2), nullptr, D, (r / 86) * 64, 64, FF, (r % 86) * 64, (r / 86) * 64}; r -= I_DN;
    if (r < I_AB) return CvtDesc{A.in[14], (bf16_t*)(ws + WS_WA), nullptr, D, (r / 16) * 64, 64, 1024, (r % 16) * 64, (r / 16) * 64}; r -= I_AB;
    if (r < I_AB) return CvtDesc{A.in[15], (bf16_t*)(ws + WS_WB), nullptr, D, (r / 16) * 64, 64, 1024, (r % 16) * 64, (r / 16) * 64}; r -= I_AB;
    return CvtDesc{A.in[16], (bf16_t*)(ws + WS_WOUT), nullptr, D, (r / 32) * 64, 64, D, (r % 32) * 64, (r / 32) * 64};
}
template <bool NT = false> __device__ __forceinline__ void cvt_items(const Ptrs& A, LAS unsigned char* lds, int gw, int NGW, int it_lo, int it_hi, int lo2 = 0, int hi2 = 0) {
    const int tid = threadIdx.x, lane = tid & 63, wave = tid >> 6;
    LAS float* scr = (LAS float*)(lds + wave * 16640);
    const int n1 = it_hi - it_lo, ntot = n1 + (hi2 - lo2);
#define CVT_MAP(v) ((v) < n1 ? it_lo + (v) : lo2 + ((v) - n1))
    int it = gw; if (it >= ntot) return;
    CvtDesc d = cvt_decode(A, CVT_MAP(it)); f32x4 v[16]; cvt_load<NT>(d, lane, v);
    for (;;) {
        const int itn = it + NGW; const bool has = itn < ntot;
        CvtDesc dn = d; f32x4 w[16];
        if (has) { dn = cvt_decode(A, CVT_MAP(itn)); cvt_load<NT>(dn, lane, w); }
        cvt_store<NT>(d, v, scr, lane);
        if (!has) break;
        d = dn; it = itn;
#pragma unroll
        for (int i = 0; i < 16; ++i) v[i] = w[i];
    }
#undef CVT_MAP
}
__device__ __forceinline__ void p0_prologue(const Ptrs& A, LAS unsigned char* lds, int vcu, int G) {
    const int tid = threadIdx.x, lane = tid & 63, wave = tid >> 6;
    unsigned char* ws = A.ws; float* ctl = (float*)(ws + WS_CTL);
    const int gw = vcu * 8 + wave, NGW = G * 8;
    if (LATE_CVT && G == 256) cvt_items(A, lds, gw, NGW, R_GU1, R_DN1, R_IN, IN_SPLIT);
    else cvt_items(A, lds, gw, NGW, 0, NITEMS);
    const float* x = A.in[0]; bf16_t* XB = (bf16_t*)(ws + WS_XB);
    for (int m = gw; m < T; m += NGW) {
        const f32x4* xr = (const f32x4*)(x + (size_t)m * D) + lane; f32x4 v[8]; float s = 0.f;
#pragma unroll
        for (int j = 0; j < 8; ++j) { v[j] = xr[64 * j]; s += (v[j][0] * v[j][0] + v[j][1] * v[j][1]) + (v[j][2] * v[j][2] + v[j][3] * v[j][3]); }
        s = wave_sum(s);
        u32x2* o8 = (u32x2*)(XB + (size_t)m * D) + lane;
#pragma unroll
        for (int j = 0; j < 8; ++j) { u32x2 w; w.x = cvt_pk_bf16(v[j][0], v[j][1]); w.y = cvt_pk_bf16(v[j][2], v[j][3]); o8[64 * j] = w; }
        if (lane == 0) ctl[CW_SS1 + m] = s;
    }
    for (int i = vcu * 512 + tid; i < 16384; i += G * 512) ctl[CW_SS2 + i] = 0.f;
    if (vcu == 0 && wave == 0) {
        const float* qw = A.in[11]; const float* kw = A.in[12];
        float mq = fmaxf(fabsf(qw[lane]), fabsf(qw[lane + 64])), mk = fmaxf(fabsf(kw[lane]), fabsf(kw[lane + 64]));
#pragma unroll
        for (int o = 1; o < 64; o <<= 1) { mq = fmaxf(mq, __shfl_xor(mq, o)); mk = fmaxf(mk, __shfl_xor(mk, o)); }
        if (lane == 0) ctl[CW_SHIFT] = 11.313708498984761f * mq * mk * L2E;
    }
}
#define RLX_AGENT __ATOMIC_RELAXED, __HIP_MEMORY_SCOPE_AGENT
#define XB_TMO      128
#define XB_XCNT(j)  (256  + 64 * (j))
#define XB_XSUB(j)  (1280 + 64 * (j))
#define XB_XGEN(j)  (2304 + 64 * (j))
#define XB_TOP      3328
#define XB_TOPGEN   3392
#define XCD_BAR_WORDS 3456
#define XB_SPIN_CAP (1u << 18)

__device__ __forceinline__ unsigned xb_ld(unsigned* p)              { return __hip_atomic_load(p, __ATOMIC_RELAXED, __HIP_MEMORY_SCOPE_AGENT); }
__device__ __forceinline__ unsigned xb_add(unsigned* p, unsigned v) { return __hip_atomic_fetch_add(p, v, __ATOMIC_RELAXED, __HIP_MEMORY_SCOPE_AGENT); }
__device__ __forceinline__ unsigned xb_xcc_id() { return (unsigned)__builtin_amdgcn_s_getreg((3 << 11) | 20) & 0xFu; }
#define XB_SPIN(cond, bar) do { unsigned _sp = 0; while (cond) { __builtin_amdgcn_s_sleep(1); \
    if ((++_sp & 255u) == 0u) { if (xb_ld(&(bar)[XB_TMO])) break; if (_sp > XB_SPIN_CAP) { atomicAdd(&(bar)[XB_TMO], 1u); break; } } } } while (0)

struct XcdBarrier {
    unsigned* bar; unsigned x;
    volatile LAS unsigned* st;
};

__device__ __forceinline__ XcdBarrier xcd_barrier_post(unsigned* bar, volatile LAS unsigned* st) {
    XcdBarrier b; b.bar = bar; b.x = xb_xcc_id(); b.st = st;
    if (threadIdx.x == 0) (void)xb_add(&bar[XB_XCNT(b.x)], 1u);
    return b;
}
__device__ __forceinline__ void xcd_barrier_complete(unsigned* bar, unsigned x, unsigned& nloc, unsigned& nx) {
    const unsigned G = gridDim.x * gridDim.y * gridDim.z;
    unsigned sum, cnt, mine, sp = 0u;
    for (;;) {
        sum = 0u; cnt = 0u; mine = 0u;
#pragma unroll
        for (unsigned j = 0; j < 16; ++j) { const unsigned c = xb_ld(&bar[XB_XCNT(j)]); sum += c; cnt += (c > 0u) ? 1u : 0u; mine = (j == x) ? c : mine; }
        if (sum == G) break;
        __builtin_amdgcn_s_sleep(1);
        if ((++sp & 255u) == 0u) { if (xb_ld(&bar[XB_TMO])) break; if (sp > XB_SPIN_CAP) { atomicAdd(&bar[XB_TMO], 1u); break; } }
    }
    nloc = mine > 0u ? mine : 1u; nx = cnt > 0u ? cnt : 1u;
}

__device__ __forceinline__ void xcd_barrier(const XcdBarrier& b) {
    asm volatile("s_waitcnt vmcnt(0)" ::: "memory");
    __syncthreads();
    if (threadIdx.x == 0) {
        unsigned* bar = b.bar;
        __builtin_amdgcn_s_waitcnt(0);
        unsigned nloc = b.st[0], nx = b.st[1];
        if (nloc == 0u) { xcd_barrier_complete(bar, b.x, nloc, nx); b.st[0] = nloc; b.st[1] = nx; }
        const unsigned old = xb_add(&bar[XB_XSUB(b.x)], 1u);
        const unsigned gen = old / nloc;
        if (old + 1u == (gen + 1u) * nloc) {
            __builtin_amdgcn_fence(__ATOMIC_RELEASE, "agent");
            asm volatile("s_waitcnt vmcnt(0)" ::: "memory");
            const unsigned og = xb_add(&bar[XB_TOP], 1u);
            const unsigned tg = og / nx;
            if (og + 1u == (tg + 1u) * nx) xb_add(&bar[XB_TOPGEN], 1u);
            else XB_SPIN(xb_ld(&bar[XB_TOPGEN]) == tg, bar);
            __builtin_amdgcn_fence(__ATOMIC_ACQUIRE, "agent");
            xb_add(&bar[XB_XGEN(b.x)], 1u);
            asm volatile("s_waitcnt vmcnt(0)" ::: "memory");
        } else {
            XB_SPIN(xb_ld(&bar[XB_XGEN(b.x)]) == gen, bar);
            __builtin_amdgcn_fence(__ATOMIC_ACQUIRE, "agent");
            asm volatile("s_waitcnt vmcnt(0)" ::: "memory");
        }
    }
    __syncthreads();
}
template <int MODE = 7> __device__ __forceinline__ void gdn_prep_unit(LAS unsigned char* lds, int c, int h, bf16_t* P, const float* AB, const float* convw, const float* A_log, const float* dt_bias, const float* kw,
                                              bf16_t* WN, bf16_t* QG, bf16_t* KDT, float* U, bf16_t* AQK, float* CD) {
    const int tid = threadIdx.x, lane = tid & 63, wave = __builtin_amdgcn_readfirstlane(tid >> 6);
    LAS bf16_t* KT = (LAS bf16_t*)(lds); LAS bf16_t* KBT = (LAS bf16_t*)(lds + 17408); LAS bf16_t* QT = (LAS bf16_t*)(lds + 34816);
    LAS float* X = (LAS float*)(lds + 52224); LAS float* AS = (LAS float*)(lds + 117760);
    LAS float* GS = (LAS float*)(lds + 134144); LAS float* BS = GS + 64; LAS float* GC = GS + 128; LAS float* ED = GS + 192;
    const int i = tid >> 3, sub = tid & 7, d0 = sub * 16, t = c * 64 + i;
    float ab_a = 0.f, ab_b = 0.f;
    if (sub == 0) { ab_a = AB[(size_t)t * 16 + h]; ab_b = AB[(size_t)t * 16 + 8 + h]; }
    u32x4 av0 = {0u, 0u, 0u, 0u}, av1 = {0u, 0u, 0u, 0u};
    if (MODE & 1) {   bf16_t* kp = P + (size_t)t * NP + P_AK + h * 128 + d0; const bf16_t* vp = P + (size_t)t * NP + P_AV + h * 128 + d0;
        float kv[16], kwv[16]; ld16bf(kp, kv); av0 = *(const u32x4*)vp; av1 = *(const u32x4*)(vp + 8); ld16f(kw + d0, kwv);
        float ss = 0.f;
#pragma unroll
        for (int e = 0; e < 16; ++e) ss += kv[e] * kv[e];
        ss += __shfl_xor(ss, 1); ss += __shfl_xor(ss, 2); ss += __shfl_xor(ss, 4);
        const float rs = rsqrtf(ss * (1.0f / 128.0f) + EPS);
#pragma unroll
        for (int e = 0; e < 16; ++e) kv[e] *= rs * kwv[e];
        st16bf_g(kp, kv);
        *(LAS u32x4*)(KT + i * 136 + d0) = av0; *(LAS u32x4*)(KT + i * 136 + d0 + 8) = av1;
    }
    float q[16], k[16], v[16];
#pragma unroll
    for (int sec = 0; sec < 3; ++sec) {
        float acc[16];
#pragma unroll
        for (int e = 0; e < 16; ++e) acc[e] = 0.f;
        const int col = sec * 1024 + h * 128 + d0;
#pragma unroll
        for (int kk = 0; kk < 4; ++kk) {
            const int tt = t - 3 + kk;
            if (tt >= 0) { float xv[16], wv[16]; ld16bf(P + (size_t)tt * NP + col, xv); ld16f(convw + kk * 3072 + col, wv);
#pragma unroll
                for (int e = 0; e < 16; ++e) acc[e] += wv[e] * xv[e]; }
        }
#pragma unroll
        for (int e = 0; e < 16; ++e) { const float r = siluf_(acc[e]); if (sec == 0) q[e] = r; else if (sec == 1) k[e] = r; else v[e] = r; }
    }
    float sq = 0.f, sk = 0.f;
#pragma unroll
    for (int e = 0; e < 16; ++e) { sq += q[e] * q[e]; sk += k[e] * k[e]; }
    sq += __shfl_xor(sq, 1); sq += __shfl_xor(sq, 2); sq += __shfl_xor(sq, 4);
    sk += __shfl_xor(sk, 1); sk += __shfl_xor(sk, 2); sk += __shfl_xor(sk, 4);
    const float rq = rsqrtf(sq + EPS) * 0.08838834764831845f, rk = rsqrtf(sk + EPS);
#pragma unroll
    for (int e = 0; e < 16; ++e) { q[e] *= rq; k[e] *= rk; }
    if (sub == 0) { const float a = ab_a, b = ab_b; const float xx = a + dt_bias[h];
        const float sp = fmaxf(xx, 0.f) + log1pf(expf(-fabsf(xx)));
        GS[i] = -expf(A_log[h]) * sp; BS[i] = 1.0f / (1.0f + expf(-b)); }
    BAR_LDS();
    if (MODE & 1) {
#pragma unroll
        for (int q2 = 0; q2 < 2; ++q2) { const int ch = tid + 512 * q2, d = ch & 127, k8 = ch >> 7; const LAS bf16_t* vp = KT + (8 * k8) * 136 + d;
            u32x4 w; w.x = (unsigned)vp[0] | ((unsigned)vp[136] << 16); w.y = (unsigned)vp[2 * 136] | ((unsigned)vp[3 * 136] << 16);
            w.z = (unsigned)vp[4 * 136] | ((unsigned)vp[5 * 136] << 16); w.w = (unsigned)vp[6 * 136] | ((unsigned)vp[7 * 136] << 16);
            *(u32x4*)(P + (size_t)(c * 64 + (d >> 1)) * NP + P_AV + h * 128 + (d & 1) * 64 + 8 * k8) = w; }
    }
    if (wave == 0) { float g = GS[lane];
#pragma unroll
        for (int o = 1; o < 64; o <<= 1) { const float y = __shfl_up(g, o); if (lane >= o) g += y; }
        GC[lane] = g; ED[lane] = __expf(__shfl(g, 63) - g); }
    BAR_LDS();
    const float beta = BS[i], Gi = GC[i], Gl = GC[63];
    const float eg = __expf(Gi);
    float tmp[16];
    if (!(MODE & 8)) {
    st16bf_l(KT + i * 136 + d0, k);
#pragma unroll
    for (int e = 0; e < 16; ++e) tmp[e] = k[e] * beta;
    st16bf_l(KBT + i * 136 + d0, tmp);
    st16bf_l(QT + i * 136 + d0, q);
#pragma unroll
    for (int e = 0; e < 4; ++e) {
        *(LAS f32x4*)(X + i * 256 + d0 + 4 * e) = (f32x4){v[4 * e] * beta, v[4 * e + 1] * beta, v[4 * e + 2] * beta, v[4 * e + 3] * beta};
        *(LAS f32x4*)(X + i * 256 + 128 + d0 + 4 * e) = (f32x4){tmp[4 * e] * eg, tmp[4 * e + 1] * eg, tmp[4 * e + 2] * eg, tmp[4 * e + 3] * eg}; }
    }
    if (!(MODE & 16)) {
#pragma unroll
    for (int e = 0; e < 16; ++e) tmp[e] = q[e] * eg;
    const size_t pk_off = ((size_t)h * NCH + c) * 8192 + (size_t)((i >> 4) * 4 + (sub >> 1)) * 512 + (size_t)((((2 * sub) & 3) * 16 + (i & 15)) * 8);
    { u32x4 a, b; pack16(tmp, a, b); *(u32x4*)(QG + pk_off) = a; *(u32x4*)(QG + pk_off + 128) = b; }
    }
    BAR_LDS();
    if (!(MODE & 16)) {
        bf16_t* kdb = KDT + ((size_t)h * NCH + c) * 8192;
#pragma unroll
        for (int q2 = 0; q2 < 2; ++q2) { const int ch = tid + 512 * q2, d = ch & 127, i8 = ch >> 7; const LAS bf16_t* kp = KT + (8 * i8) * 136 + d; const LAS float* ep = ED + 8 * i8;
            float kv[8];
#pragma unroll
            for (int r = 0; r < 8; ++r) kv[r] = __uint_as_float((unsigned)kp[r * 136] << 16) * ep[r];
            u32x4 w; w.x = cvt_pk_bf16(kv[0], kv[1]); w.y = cvt_pk_bf16(kv[2], kv[3]); w.z = cvt_pk_bf16(kv[4], kv[5]); w.w = cvt_pk_bf16(kv[6], kv[7]);
            *(u32x4*)(kdb + (size_t)((d >> 4) * 2 + (i8 >> 2)) * 512 + (size_t)((i8 & 3) * 16 + (d & 15)) * 8) = w; }
    }
    if (MODE & 2) {
        const int fr = lane & 15, fq = lane >> 4, mt = wave >> 2, it = wave & 3;
        const LAS bf16_t* Asrc = mt ? QT : KBT;
        bf16x8 af[4];
#pragma unroll
        for (int kk = 0; kk < 4; ++kk) af[kk] = *(const LAS bf16x8*)(Asrc + (16 * it + fr) * 136 + 32 * kk + 8 * fq);
        bf16_t* aqk = AQK + ((size_t)h * NCH + c) * 4096;
        for (int jt = 0; jt < 4; ++jt) {
            f32x4 acc = {0.f, 0.f, 0.f, 0.f};
            if (jt <= it) {
#pragma unroll
                for (int kk = 0; kk < 4; ++kk) { const bf16x8 b = *(const LAS bf16x8*)(KT + (16 * jt + fr) * 136 + 32 * kk + 8 * fq); acc = MFMA16(af[kk], b, acc); }
            }
            const int j = 16 * jt + fr; const float Gj = GC[j];
#pragma unroll
            for (int r = 0; r < 4; ++r) { const int ii = 16 * it + 4 * fq + r; const float Gii = GC[ii];
                const bool keep = mt ? (ii >= j) : (ii > j);
                const float val = keep ? acc[r] * __expf(fminf(Gii - Gj, 0.f)) : 0.f;
                if (mt == 0) AS[ii * 64 + j] = val; else aqk[((ii >> 4) * 2 + (j >> 5)) * 512 + (((j >> 3) & 3) * 16 + (ii & 15)) * 8 + (j & 7)] = f2bf1(val); }
        }
    }
    BAR_LDS();
    LAS float* TB = (LAS float*)(lds + 135168);
    if ((MODE & 4) && wave == 0) {
        const int bb = lane >> 4, jc = lane & 15; const LAS float* Ab = AS + (16 * bb) * 64 + 16 * bb;
        float tc[16];
#pragma unroll
        for (int r = 0; r < 16; ++r) { float a0 = (r == jc) ? 1.f : 0.f;
#pragma unroll
            for (int m = 0; m < r; ++m) a0 -= Ab[r * 64 + m] * tc[m];
            tc[r] = a0; }
#pragma unroll
        for (int r = 0; r < 16; ++r) TB[bb * 256 + r * 16 + jc] = tc[r];
    }
    BAR_LDS();
    if (MODE & 4) {   const int fr = lane & 15, fq = lane >> 4;
        f32x4 acc[4][2];
#pragma unroll
        for (int rb = 0; rb < 4; ++rb)
#pragma unroll
            for (int q2 = 0; q2 < 2; ++q2) { const LAS float* xp = X + (16 * rb + 4 * fq) * 256 + 32 * wave + 16 * q2 + fr; acc[rb][q2] = (f32x4){xp[0], xp[256], xp[512], xp[768]}; }
#pragma unroll
        for (int bb = 0; bb < 4; ++bb) {
            const f32x4 tf = *(const LAS f32x4*)(TB + bb * 256 + fr * 16 + 4 * fq); const bf16x4 ta = mk4(tf[0], tf[1], tf[2], tf[3]);
            bf16x4 xb[2];
#pragma unroll
            for (int q2 = 0; q2 < 2; ++q2) { const bf16x4 rbf = mk4(acc[bb][q2][0], acc[bb][q2][1], acc[bb][q2][2], acc[bb][q2][3]);
                acc[bb][q2] = MFMA16K16(ta, rbf, ((f32x4){0.f, 0.f, 0.f, 0.f}));
                xb[q2] = mk4(acc[bb][q2][0], acc[bb][q2][1], acc[bb][q2][2], acc[bb][q2][3]); }
#pragma unroll
            for (int ib = bb + 1; ib < 4; ++ib) { const f32x4 af = *(const LAS f32x4*)(AS + (16 * ib + fr) * 64 + 16 * bb + 4 * fq); const bf16x4 na = mk4(-af[0], -af[1], -af[2], -af[3]);
#pragma unroll
                for (int q2 = 0; q2 < 2; ++q2) acc[ib][q2] = MFMA16K16(na, xb[q2], acc[ib][q2]); }
        }
        if (wave < 4) {
            float* up = U + ((size_t)h * NCH + c) * 8192;
#pragma unroll
            for (int rb = 0; rb < 4; ++rb)
#pragma unroll
                for (int q2 = 0; q2 < 2; ++q2) *(f32x4*)(up + (size_t)(((2 * wave + q2) * 4 + rb) * 64 + lane) * 4) = acc[rb][q2];
        } else {
            bf16_t* wp = WN + ((size_t)h * NCH + c) * 8192 + (size_t)(wave - 4) * 512 + (size_t)((fr >> 3) * 16 + 4 * fq) * 8 + (fr & 7);
#pragma unroll
            for (int rb = 0; rb < 4; ++rb)
#pragma unroll
                for (int q2 = 0; q2 < 2; ++q2)
#pragma unroll
                    for (int r = 0; r < 4; ++r) wp[(size_t)rb * 2048 + (size_t)(2 * q2 * 16 + r) * 8] = f2bf1(-acc[rb][q2][r]);
        }
        if (tid == 0) CD[h * NCH + c] = expf(Gl);
    }
    BAR_LDS();
}

__device__ __forceinline__ void gdn_scan(LAS unsigned char* lds, int h, int s, const bf16_t* WN, const bf16_t* QG, const bf16_t* KDT, const float* U, const bf16_t* AQK, const float* CD,
                                         bf16_t* Oraw, int opitch) {
    const int tid = threadIdx.x, lane = tid & 63, wave = __builtin_amdgcn_readfirstlane(tid >> 6), fr = lane & 15, fq = lane >> 4, e0 = 16 * s;
    LAS bf16_t* ST = (LAS bf16_t*)lds;
    LAS bf16_t* VT = (LAS bf16_t*)(lds + 4352);
    for (int idx = tid; idx < 16 * 136 / 2; idx += 512) ((LAS unsigned*)ST)[idx] = 0u;
    BAR_LDS();
    const bool lo = wave < 4; const int it = wave & 3;
    const bf16_t* a1p = (lo ? WN : QG) + (size_t)h * NCH * 8192 + (size_t)(it * 4) * 512 + lane * 8;
    const bf16_t* aqp = AQK + (size_t)h * NCH * 4096 + (size_t)(it * 2) * 512 + lane * 8;
    const bf16_t* kdp = KDT + (size_t)h * NCH * 8192 + (size_t)(wave * 2) * 512 + lane * 8;
    const float* up = U + (size_t)h * NCH * 8192 + (size_t)((s * 4 + it) * 64 + lane) * 4;
    bf16_t* op = Oraw + (size_t)(16 * it + 4 * fq) * opitch + h * 128 + e0 + fr;
    f32x4 S = {0.f, 0.f, 0.f, 0.f};
    constexpr int PD = 4;
    bf16x8 rA1[PD][4], rAq[PD][2], rKd[PD][2]; f32x4 rU[PD]; float rcd[PD];
#define SCAN_LOAD(st, cc) do { const size_t c_ = (size_t)(cc); \
        _Pragma("unroll") for (int kk = 0; kk < 4; ++kk) rA1[st][kk] = *(const bf16x8*)(a1p + c_ * 8192 + 512 * kk); \
        _Pragma("unroll") for (int kk = 0; kk < 2; ++kk) rKd[st][kk] = *(const bf16x8*)(kdp + c_ * 8192 + 512 * kk); \
        if (lo) rU[st] = *(const f32x4*)(up + c_ * 8192); \
        else { _Pragma("unroll") for (int kk = 0; kk < 2; ++kk) rAq[st][kk] = *(const bf16x8*)(aqp + c_ * 4096 + 512 * kk); } \
        rcd[st] = CD[h * NCH + (cc)]; } while (0)
#pragma unroll
    for (int st = 0; st < PD; ++st) { rU[st] = (f32x4){0.f, 0.f, 0.f, 0.f}; rAq[st][0] = rAq[st][1] = (bf16x8){0, 0, 0, 0, 0, 0, 0, 0}; SCAN_LOAD(st, st); }
#pragma unroll 8
    for (int c0 = 0; c0 < NCH; c0 += PD) {
#pragma unroll
        for (int st = 0; st < PD; ++st) {
            const int c = c0 + st;
            f32x4 acc = rU[st];
#pragma unroll
            for (int kk = 0; kk < 4; ++kk) { const bf16x8 sb = *(const LAS bf16x8*)(ST + fr * 136 + 32 * kk + 8 * fq); acc = MFMA16(rA1[st][kk], sb, acc); }
            if (lo) { u32x2 w; w.x = cvt_pk_bf16(acc[0], acc[1]); w.y = cvt_pk_bf16(acc[2], acc[3]); *(LAS u32x2*)(VT + fr * 72 + 16 * it + 4 * fq) = w; }
            BAR_LDS();
            bf16x8 vb[2];
#pragma unroll
            for (int kk = 0; kk < 2; ++kk) vb[kk] = *(const LAS bf16x8*)(VT + fr * 72 + 32 * kk + 8 * fq);
            if (!lo) {
#pragma unroll
                for (int kk = 0; kk < 2; ++kk) acc = MFMA16(rAq[st][kk], vb[kk], acc);
#pragma unroll
                for (int r = 0; r < 4; ++r) op[((size_t)c * 64 + r) * opitch] = f2bf1(acc[r]);
            }
            S = S * rcd[st];
#pragma unroll
            for (int kk = 0; kk < 2; ++kk) S = MFMA16(rKd[st][kk], vb[kk], S);
            { u32x2 w; w.x = cvt_pk_bf16(S[0], S[1]); w.y = cvt_pk_bf16(S[2], S[3]); *(LAS u32x2*)(ST + fr * 136 + 16 * wave + 4 * fq) = w; }
            if (c + PD < NCH) SCAN_LOAD(st, c + PD);
            BAR_LDS();
        }
    }
#undef SCAN_LOAD
}

__device__ __forceinline__ void attn_unit(LAS unsigned char* lds, int n, int h, const bf16_t* P, const float* qw, const float* relb, float shift, bf16_t* OA) {
    const int tid = threadIdx.x, lane = tid & 63, wave = __builtin_amdgcn_readfirstlane(tid >> 6), fr = lane & 15, fq = lane >> 4, it = wave >> 1, kh = wave & 1;
    LAS bf16_t* KS = (LAS bf16_t*)lds; LAS bf16_t* VTS = (LAS bf16_t*)(lds + 17408); LAS float* BIAS = (LAS float*)(lds + 34816);
    for (int idx = tid; idx < 320; idx += 512) BIAS[idx] = relb[h * 320 + idx] * L2E;
    bf16x8 qf[4];
    {   const bf16_t* qp = P + (size_t)(n * 64 + 16 * it + fr) * NP + P_AQ + h * 128 + 8 * fq;
        float qv[4][8]; float ss = 0.f;
#pragma unroll
        for (int kk = 0; kk < 4; ++kk) { const u32x4 a = *(const u32x4*)(qp + 32 * kk);
            qv[kk][0] = bf_lo(a.x); qv[kk][1] = bf_hi(a.x); qv[kk][2] = bf_lo(a.y); qv[kk][3] = bf_hi(a.y); qv[kk][4] = bf_lo(a.z); qv[kk][5] = bf_hi(a.z); qv[kk][6] = bf_lo(a.w); qv[kk][7] = bf_hi(a.w);
#pragma unroll
            for (int e = 0; e < 8; ++e) ss += qv[kk][e] * qv[kk][e]; }
        ss += __shfl_xor(ss, 16); ss += __shfl_xor(ss, 32);
        const float rs = rsqrtf(ss * (1.0f / 128.0f) + EPS) * (0.08838834764831845f * L2E);
#pragma unroll
        for (int kk = 0; kk < 4; ++kk) { const float* wp = qw + 32 * kk + 8 * fq; const f32x4 w0 = *(const f32x4*)wp, w1 = *(const f32x4*)(wp + 4);
            qf[kk] = mk8(cvt_pk_bf16(qv[kk][0] * rs * w0[0], qv[kk][1] * rs * w0[1]), cvt_pk_bf16(qv[kk][2] * rs * w0[2], qv[kk][3] * rs * w0[3]),
                         cvt_pk_bf16(qv[kk][4] * rs * w1[0], qv[kk][5] * rs * w1[1]), cvt_pk_bf16(qv[kk][6] * rs * w1[2], qv[kk][7] * rs * w1[3])); }
    }
    const int kt_lo = (n >= 8) ? 0 : 8 - n;
    const int key = tid >> 3, sub = tid & 7, vd = tid >> 2, vpart = tid & 3;
    u32x4 nk0, nk1, nv0, nv1;
#define ATT_LOAD(kt_) do { const bf16_t* rp = P + (size_t)((n - 8 + (kt_)) * 64 + key) * NP + h * 128 + 16 * sub + P_AK; \
        const bf16_t* vq = P + (size_t)((n - 8 + (kt_)) * 64 + (vd >> 1)) * NP + P_AV + h * 128 + (vd & 1) * 64 + 16 * vpart; \
        nk0 = *(const u32x4*)(rp); nk1 = *(const u32x4*)(rp + 8); nv0 = *(const u32x4*)(vq); nv1 = *(const u32x4*)(vq + 8); } while (0)
    ATT_LOAD(kt_lo);
    f32x4 oacc[8];
#pragma unroll
    for (int dt = 0; dt < 8; ++dt) oacc[dt] = (f32x4){0.f, 0.f, 0.f, 0.f};
    float lsum = 0.f;
    for (int kt = kt_lo; kt < 9; ++kt) {
        {   *(LAS u32x4*)(KS + key * 136 + 16 * sub) = nk0; *(LAS u32x4*)(KS + key * 136 + 16 * sub + 8) = nk1;
            LAS bf16_t* vrow = VTS + vd * 68; const int dtw = vd >> 4, g0 = 4 * vpart;
            *(LAS u32x2*)(vrow + (((g0 + 0) ^ dtw) << 2)) = (u32x2){nv0.x, nv0.y}; *(LAS u32x2*)(vrow + (((g0 + 1) ^ dtw) << 2)) = (u32x2){nv0.z, nv0.w};
            *(LAS u32x2*)(vrow + (((g0 + 2) ^ dtw) << 2)) = (u32x2){nv1.x, nv1.y}; *(LAS u32x2*)(vrow + (((g0 + 3) ^ dtw) << 2)) = (u32x2){nv1.z, nv1.w};
        }
        BAR_LDS();
        if (kt + 1 < 9) ATT_LOAD(kt + 1);
        unsigned pk[2][2];
#pragma unroll
        for (int kt2 = 0; kt2 < 2; ++kt2) { const int kb = 32 * kh + 16 * kt2; f32x4 acc = {0.f, 0.f, 0.f, 0.f};
#pragma unroll
            for (int kk = 0; kk < 4; ++kk) { const bf16x8 a = *(const LAS bf16x8*)(KS + (kb + fr) * 136 + 32 * kk + 8 * fq); acc = MFMA16(a, qf[kk], acc); }
            float p[4];
#pragma unroll
            for (int r = 0; r < 4; ++r) { const int jband = 64 * kt + kb + 4 * fq + r; int rel = (16 * it + fr) - jband + 512; rel = rel < -63 ? -63 : (rel > 256 ? 256 : rel);
                p[r] = __builtin_amdgcn_exp2f(acc[r] + BIAS[rel + 63] - shift); lsum += p[r]; }
            pk[kt2][0] = cvt_pk_bf16(p[0], p[1]); pk[kt2][1] = cvt_pk_bf16(p[2], p[3]); }
        const bf16x8 pf = mk8(pk[0][0], pk[0][1], pk[1][0], pk[1][1]);
#pragma unroll
        for (int dt = 0; dt < 8; ++dt) { const LAS bf16_t* vrow = VTS + (16 * dt + fr) * 68; const int g0 = 8 * kh + fq;
            const u32x2 a0 = *(const LAS u32x2*)(vrow + (((g0) ^ dt) << 2)), a1 = *(const LAS u32x2*)(vrow + (((g0 + 4) ^ dt) << 2));
            oacc[dt] = MFMA16(mk8(a0.x, a0.y, a1.x, a1.y), pf, oacc[dt]); }
        BAR_LDS();
    }
#undef ATT_LOAD
    lsum += __shfl_xor(lsum, 16); lsum += __shfl_xor(lsum, 32);
    LAS float* CB = (LAS float*)lds;
    if (kh == 1) {
#pragma unroll
        for (int dt = 0; dt < 8; ++dt)
#pragma unroll
            for (int r = 0; r < 4; ++r) CB[(it * 33 + dt * 4 + r) * 64 + lane] = oacc[dt][r];
        CB[(it * 33 + 32) * 64 + lane] = lsum; }
    BAR_LDS();
    if (kh == 0) {
#pragma unroll
        for (int dt = 0; dt < 8; ++dt)
#pragma unroll
            for (int r = 0; r < 4; ++r) oacc[dt][r] += CB[(it * 33 + dt * 4 + r) * 64 + lane];
        lsum += CB[(it * 33 + 32) * 64 + lane];
        const float inv = 1.0f / lsum;
        bf16_t* op = OA + (size_t)(n * 64 + 16 * it + fr) * 1024 + h * 128 + 4 * fq;
#pragma unroll
        for (int dt = 0; dt < 8; ++dt) { u32x2 w; w.x = cvt_pk_bf16(oacc[dt][0] * inv, oacc[dt][1] * inv); w.y = cvt_pk_bf16(oacc[dt][2] * inv, oacc[dt][3] * inv); *(u32x2*)(op + 16 * dt) = w; }
    }
    BAR_LDS();
}
struct Args { const float* in[21]; float* out; unsigned char* ws; int ph_lo, ph_hi; };
constexpr int NPHASE = 11;
__global__ void __launch_bounds__(512, 2) hybrid_fwd(Args args) {
    extern __shared__ __attribute__((aligned(16))) unsigned char lds_raw[];
    LAS unsigned char* lds = (LAS unsigned char*)lds_raw;
    if (threadIdx.x < 16) ((LAS unsigned*)(lds + LDS_BYTES - 64))[threadIdx.x] = 0u;
    __syncthreads();
    XcdBarrier bar; bar.bar = nullptr; bar.x = 0; bar.st = nullptr;
    if (args.ph_hi - args.ph_lo > 1) bar = xcd_barrier_post((unsigned*)(args.ws + WS_BAR), (volatile LAS unsigned*)(lds + LDS_BYTES - 64));
    const int tid = threadIdx.x, lane = tid & 63, wave = __builtin_amdgcn_readfirstlane(tid >> 6);
    const int G = gridDim.x, bx = blockIdx.x;
    unsigned char* ws = args.ws; float* ctl = (float*)(ws + WS_CTL);
    bf16_t* XB = (bf16_t*)(ws + WS_XB); bf16_t* Pb = (bf16_t*)(ws + WS_P);
    float* xres = args.out;
    const int lo = args.ph_lo, hi = args.ph_hi;
#define IN(k) (lo <= (k) && (k) < hi)
#ifndef DUP_MASK
#define DUP_MASK 0
#endif
#define REP(k) for (int rep_ = 0; rep_ < (((DUP_MASK >> (k)) & 1) ? 2 : 1); ++rep_)
#define REPBAR() do { if (rep_) xcd_barrier(bar); } while (0)
#define SEAM(k) do { if (IN(k) && IN((k) + 1)) xcd_barrier(bar); } while (0)

    Ptrs A; for (int i = 0; i < 21; ++i) A.in[i] = args.in[i]; A.out = args.out; A.ws = ws;
    if (IN(0)) REP(0) { REPBAR(); p0_prologue(A, lds, bx, G); }
    SEAM(0);
    if (IN(1)) REP(1) { REPBAR();
        pg8::Gemm g{XB, (const bf16_t*)(ws + WS_WGU1), T, NGU, D}; pg8::StaticOrder S; S.init(T, NGU, G, bx);
        pg8::EpiSwiglu E{(bf16_t*)(ws + WS_ACT1), FF, ctl + CW_SS1};
        pg8::gemm_phase<pg8::EpiSwiglu, pg8::StaticOrder, true, true>(lds, g, S, E);
        if (LATE_CVT && bx >= 96 && G == 256) cvt_items(A, lds, (bx - 96) * 8 + wave, 160 * 8, R_DN1, R_IN, IN_SPLIT, GU2_SPLIT);
    }
    SEAM(1);
    if (IN(2)) {
        pg8::Gemm g{(const bf16_t*)(ws + WS_ACT1), (const bf16_t*)(ws + WS_WD1), T, D, FF}; pg8::StaticOrder S; S.init(T, D, G, bx);
        pg8::EpiResid<true> E{args.in[0], xres, XB, ctl + CW_SS2, 0.5f};
        pg8::gemm_phase<pg8::EpiResid<true>, pg8::StaticOrder, false, true>(lds, g, S, E);
    }
    SEAM(2);
    if (IN(3)) REP(3) { REPBAR();
        pg8::Gemm g{XB, (const bf16_t*)(ws + WS_WIN), T, NINP, D}; pg8::StaticOrder S; S.init(T, NINP, G, bx);
        pg8::EpiP E{Pb, ctl + CW_AB, ctl + CW_SS2};
        pg8::gemm_phase<pg8::EpiP, pg8::StaticOrder, true, true>(lds, g, S, E);
        if (LATE_CVT && G == 256 && bx >= 160) cvt_items(A, lds, (bx - 160) * 8 + wave, 96 * 8, GU2_SPLIT, R_DN2);
    }
    SEAM(3);
#ifndef DBG_SKIP_GDN
    if (IN(4)) {
#ifdef PROBE_P4_MODE
        for (int u = bx; u < NCH * H; u += G)
            gdn_prep_unit<PROBE_P4_MODE>(lds, u >> 3, u & 7, Pb, ctl + CW_AB, args.in[7], args.in[8], args.in[9], args.in[12], (bf16_t*)(ws + WS_WN), (bf16_t*)(ws + WS_QG), (bf16_t*)(ws + WS_KDT),
                          (float*)(ws + WS_U), (bf16_t*)(ws + WS_AQK), ctl + CW_CD);
        xcd_barrier(bar);
#endif
        for (int u = bx; u < NCH * H; u += G)
            gdn_prep_unit(lds, u >> 3, u & 7, Pb, ctl + CW_AB, args.in[7], args.in[8], args.in[9], args.in[12], (bf16_t*)(ws + WS_WN), (bf16_t*)(ws + WS_QG), (bf16_t*)(ws + WS_KDT),
                          (float*)(ws + WS_U), (bf16_t*)(ws + WS_AQK), ctl + CW_CD);
    }
#endif
    SEAM(4);
#define P5_BODY(part_, late_) do { \
        if (bx < 64) { if ((part_) & 1) gdn_scan(lds, bx & 7, bx >> 3, (const bf16_t*)(ws + WS_WN), (const bf16_t*)(ws + WS_QG), (const bf16_t*)(ws + WS_KDT), (const float*)(ws + WS_U), (const bf16_t*)(ws + WS_AQK), \
                              ctl + CW_CD, (bf16_t*)(ws + WS_ORAW), 1024); \
            } \
        else if ((part_) & 2) { const float shift = ctl[CW_SHIFT]; \
            for (int u = bx - 64; u < NCH * H; u += G - 64) attn_unit(lds, u >> 3, u & 7, Pb, args.in[11], args.in[13], shift, (bf16_t*)(ws + WS_OA)); \
            if (LATE_CVT && (late_) && G == 256) cvt_items(A, lds, (bx - 64) * 8 + wave, 192 * 8, R_A, R_END); } } while (0)
    if (IN(5)) {
        P5_BODY(3, 1);
#ifdef PROBE_P5_PART
        xcd_barrier(bar); P5_BODY(PROBE_P5_PART, 0);
#endif
    }
    SEAM(5);
    if (IN(6)) REP(6) { REPBAR();
        const int gw = bx * 8 + wave, NGW = G * 8; const int hh = lane >> 3, d0 = (lane & 7) * 16;
        float wv[16]; ld16f(args.in[10] + d0, wv);
        bf16_t* OG = (bf16_t*)(ws + WS_OG);
        for (int row = gw; row < T; row += NGW) {
            float o[16], z[16];
#ifdef DBG_GDN_U
            ld16f((const float*)(ws + WS_U) + (size_t)row * 1024 + hh * 128 + d0, o);
#else
            ld16bf((const bf16_t*)(ws + WS_ORAW) + (size_t)row * 1024 + hh * 128 + d0, o);
#endif
            ld16bf(Pb + (size_t)row * NP + P_GZ + hh * 128 + d0, z);
            float ss = 0.f;
#pragma unroll
            for (int e = 0; e < 16; ++e) ss += o[e] * o[e];
            ss += __shfl_xor(ss, 1); ss += __shfl_xor(ss, 2); ss += __shfl_xor(ss, 4);
            const float rs = rsqrtf(ss * (1.0f / 128.0f) + EPS);
#pragma unroll
            for (int e = 0; e < 16; ++e) o[e] = o[e] * rs * wv[e] * siluf_(z[e]);
#ifdef DBG_SKIP_GDN
            for (int e = 0; e < 16; ++e) o[e] = 0.f;
#endif
            st16bf_g(OG + (size_t)row * 1024 + hh * 128 + d0, o);
        }
    }
    SEAM(6);
    if (IN(7)) REP(7) { REPBAR();
        bf16_t* Mb = (bf16_t*)(ws + WS_M);
        { pg8::Gemm g{(const bf16_t*)(ws + WS_OG), (const bf16_t*)(ws + WS_WA), T, D, 1024}; pg8::StaticOrder S; S.init(T, D, G, bx);
          pg8::EpiGate<0> E{Mb, Pb, P_G1}; pg8::gemm_phase<pg8::EpiGate<0>, pg8::StaticOrder, false, true>(lds, g, S, E); }
        { pg8::Gemm g{(const bf16_t*)(ws + WS_OA), (const bf16_t*)(ws + WS_WB), T, D, 1024}; pg8::StaticOrder S; S.init(T, D, G, bx);
          pg8::EpiGate<1> E{Mb, Pb, P_G2}; pg8::gemm_phase<pg8::EpiGate<1>, pg8::StaticOrder, false, true>(lds, g, S, E); }
    }
    SEAM(7);
    if (IN(8)) {
        pg8::Gemm g{(const bf16_t*)(ws + WS_M), (const bf16_t*)(ws + WS_WOUT), T, D, D}; pg8::StaticOrder S; S.init(T, D, G, bx);
        pg8::EpiResid<true> E{xres, xres, XB, ctl + CW_SS3, 1.0f};
        pg8::gemm_phase<pg8::EpiResid<true>, pg8::StaticOrder, false, true>(lds, g, S, E);
    }
    SEAM(8);
    if (IN(9)) REP(9) { REPBAR();
        pg8::Gemm g{XB, (const bf16_t*)(ws + WS_WGU2), T, NGU, D}; pg8::StaticOrder S; S.init(T, NGU, G, bx);
        pg8::EpiSwiglu E{(bf16_t*)(ws + WS_ACT2), FF, ctl + CW_SS3};
        pg8::gemm_phase<pg8::EpiSwiglu, pg8::StaticOrder, true, true>(lds, g, S, E);
        if (LATE_CVT && bx >= 96 && G == 256) cvt_items(A, lds, (bx - 96) * 8 + wave, 160 * 8, R_DN2, R_A);
    }
    SEAM(9);
    if (IN(10)) {
        pg8::Gemm g{(const bf16_t*)(ws + WS_ACT2), (const bf16_t*)(ws + WS_WD2), T, D, FF}; pg8::StaticOrder S; S.init(T, D, G, bx);
        pg8::EpiResid<false> E{xres, xres, nullptr, nullptr, 0.5f};
        pg8::gemm_phase<pg8::EpiResid<false>, pg8::StaticOrder, false, true>(lds, g, S, E);
    }
#undef IN
#undef SEAM
}

extern "C" void kernel_launch(void* const* d_in, const int* in_sizes, int n_in, void* d_out, int out_size, void* d_ws, size_t ws_size, hipStream_t stream) {
    static int grid = 0;
    if (grid == 0) {
        if (n_in != 21 || out_size != T * D || ws_size < WS_END) { fprintf(stderr, "kernel_launch: unexpected problem (n_in %d, out %d, ws %zu)\n", n_in, out_size, ws_size); grid = -1; return; }
        int dev = 0, cus = 0, per_cu = 0;
        if (hipGetDevice(&dev) != hipSuccess || hipDeviceGetAttribute(&cus, hipDeviceAttributeMultiprocessorCount, dev) != hipSuccess) { grid = -1; return; }
        if (hipFuncSetAttribute((const void*)hybrid_fwd, hipFuncAttributeMaxDynamicSharedMemorySize, LDS_BYTES) != hipSuccess) { fprintf(stderr, "kernel_launch: hipFuncSetAttribute failed\n"); grid = -1; return; }
        if (hipOccupancyMaxActiveBlocksPerMultiprocessor(&per_cu, (const void*)hybrid_fwd, 512, LDS_BYTES) != hipSuccess || per_cu < 1) { fprintf(stderr, "kernel_launch: occupancy query says %d\n", per_cu); per_cu = 1; }
        (void)hipGetLastError();
        grid = cus;
    }
    if (grid < 0) return;
    if (hipMemsetAsync((char*)d_ws + WS_BAR, 0, 16384, stream) != hipSuccess) { fprintf(stderr, "kernel_launch: hipMemsetAsync failed\n"); return; }
    Args a{};
    for (int i = 0; i < 21; ++i) a.in[i] = (const float*)d_in[i];
    a.out = (float*)d_out; a.ws = (unsigned char*)d_ws;
#if N_LAUNCH == 1
    a.ph_lo = 0; a.ph_hi = NPHASE;
    void* kargs[] = {&a};
    hipError_t e = hipLaunchCooperativeKernel((const void*)hybrid_fwd, dim3(grid), dim3(512), kargs, LDS_BYTES, stream);
    if (e != hipSuccess) fprintf(stderr, "cooperative launch failed: %s (grid %d)\n", hipGetErrorString(e), grid);
#else
    for (int ph = 0; ph < NPHASE; ++ph) { a.ph_lo = ph; a.ph_hi = ph + 1; hipLaunchKernelGGL(hybrid_fwd, dim3(grid), dim3(512), LDS_BYTES, stream, a); }
#endif
}
```
